# Optimizing an MI355X kernel written in HIP

```python
import math
import jax, jax.numpy as jnp
from jax import lax
import numpy as np

D_MODEL = 2048
BATCH = 4
SEQ = 8192
DEPTH = 2
DEC_BATCH = 2
DEC_SEQ = 4096
PAST_LEN = 128

HEAD_DIM = 128
N_DIFF_HEADS = 8
DIFF_QK_DIM = HEAD_DIM // 2
N_WIN_HEADS = 8
N_WIN_KV = 2
WIN_GROUP = N_WIN_HEADS // N_WIN_KV
WINDOW = 128
BLOCK = 128
N_BUCKETS = 32
MAX_DISTANCE = 128
D_FF = 4 * D_MODEL
EPS = 1e-6
NEG = -1e30
DIFF_WIDTH = N_DIFF_HEADS * HEAD_DIM
WIN_WIDTH = N_WIN_HEADS * HEAD_DIM
MIX_WIDTH = DIFF_WIDTH + WIN_WIDTH
WIN_KV_WIDTH = N_WIN_KV * HEAD_DIM
SPLITS = (DIFF_WIDTH, DIFF_WIDTH, DIFF_WIDTH, WIN_WIDTH, WIN_KV_WIDTH, WIN_KV_WIDTH)
IN_WIDTH = sum(SPLITS)
N_HEADS_TOTAL = N_DIFF_HEADS + N_WIN_HEADS

kernel_name = "hymba_diffattn_swa_encoder"


def rmsnorm(x, g):
    xf = x.astype(jnp.float32)
    y = xf * lax.rsqrt(jnp.mean(xf * xf, axis=-1, keepdims=True) + EPS) * g.astype(jnp.float32)
    return y.astype(x.dtype)


def t5_bucket(rel):
    nb = N_BUCKETS // 2
    ret = jnp.where(rel > 0, nb, 0)
    n = jnp.abs(rel)
    max_exact = nb // 2
    nf = jnp.maximum(n, 1).astype(jnp.float32)
    large = max_exact + (jnp.log(nf / max_exact) / math.log(MAX_DISTANCE / max_exact)
                         * (nb - max_exact)).astype(jnp.int32)
    large = jnp.minimum(large, nb - 1)
    return ret + jnp.where(n < max_exact, n, large)


def diff_attention(q, k, v, lam, lambda_init, subln_g, table):
    B, S = q.shape[0], q.shape[1]
    nblk = S // BLOCK
    scale = DIFF_QK_DIM ** -0.5
    k_pos = jnp.arange(S)
    qb = q.reshape(B, nblk, BLOCK, N_DIFF_HEADS, 2, DIFF_QK_DIM).transpose(1, 0, 2, 3, 4, 5)

    def one_block(args):
        qblk, n = args
        q_pos = n * BLOCK + jnp.arange(BLOCK)
        bias = table[t5_bucket(k_pos[None, :] - q_pos[:, None])]
        bias = bias.astype(jnp.float32).transpose(2, 0, 1)[:, None]
        s = jnp.einsum('bqhcd,bkhcd->bhcqk', qblk, k).astype(jnp.float32) * scale + bias
        p = jax.nn.softmax(s, axis=-1)
        w = p[:, :, 0] - lam * p[:, :, 1]
        return jnp.einsum('bhqk,bkhe->bqhe', w.astype(v.dtype), v)

    o = lax.map(one_block, (qb, jnp.arange(nblk)))
    o = o.transpose(1, 0, 2, 3, 4).reshape(B, S, N_DIFF_HEADS, HEAD_DIM)
    o = rmsnorm(o, subln_g) * (1.0 - lambda_init)
    return o.reshape(B, S, DIFF_WIDTH)


def window_attention(q, k, v, sink, table):
    B, S = q.shape[0], q.shape[1]
    nblk = S // BLOCK
    scale = HEAD_DIM ** -0.5
    qb = q.reshape(B, nblk, BLOCK, N_WIN_KV, WIN_GROUP, HEAD_DIM)

    def band(t):
        tp = jnp.pad(t, ((0, 0), (WINDOW, WINDOW), (0, 0), (0, 0)))
        tp = tp.reshape(B, nblk + 2, BLOCK, N_WIN_KV, HEAD_DIM)
        return jnp.concatenate([tp[:, :-2], tp[:, 1:-1], tp[:, 2:]], axis=2)

    kb, vb = band(k), band(v)
    rel = jnp.arange(3 * BLOCK)[None, :] - WINDOW - jnp.arange(BLOCK)[:, None]
    key_pos = jnp.arange(nblk)[:, None] * BLOCK + jnp.arange(3 * BLOCK)[None, :] - WINDOW
    mask = (jnp.abs(rel) <= WINDOW)[None] & ((key_pos >= 0) & (key_pos < S))[:, None, :]
    bias = table[t5_bucket(rel)].astype(jnp.float32)
    bias = bias.transpose(2, 0, 1).reshape(N_WIN_KV, WIN_GROUP, BLOCK, 3 * BLOCK)
    s = jnp.einsum('bnqkgd,bnjkd->bnkgqj', qb, kb).astype(jnp.float32) * scale + bias
    s = jnp.where(mask[None, :, None, None], s, NEG)
    sink_b = sink.astype(jnp.float32).reshape(N_WIN_KV, WIN_GROUP)[None, None, :, :, None, None]
    m = jnp.maximum(jnp.max(s, axis=-1, keepdims=True), sink_b)
    e = jnp.exp(s - m)
    p = e / (jnp.sum(e, axis=-1, keepdims=True) + jnp.exp(sink_b - m))
    o = jnp.einsum('bnkgqj,bnjkd->bnqkgd', p.astype(v.dtype), vb)
    return o.reshape(B, S, WIN_WIDTH)


def trunk(x, rel_bias, norm1_g, w_in, lambda_q1, lambda_k1, lambda_q2, lambda_k2,
          diff_subln_g, sink_logit, w_out, norm2_g, w_ff_in, w_ff_out, final_norm_g):
    B, S = x.shape[0], x.shape[1]
    table_a = rel_bias[:, :N_DIFF_HEADS]
    table_b = rel_bias[:, N_DIFF_HEADS:]
    cuts = [int(c) for c in np.cumsum(SPLITS)[:-1]]
    for l in range(DEPTH):
        lambda_init = 0.8 - 0.6 * math.exp(-0.3 * l)
        lam = (jnp.exp(jnp.sum(lambda_q1[l].astype(jnp.float32) * lambda_k1[l].astype(jnp.float32)))
               - jnp.exp(jnp.sum(lambda_q2[l].astype(jnp.float32) * lambda_k2[l].astype(jnp.float32)))
               + lambda_init)
        h = rmsnorm(x, norm1_g[l])
        proj = h @ w_in[l]
        qa, ka, va, qw, kw, vw = jnp.split(proj, cuts, axis=-1)
        qa = qa.reshape(B, S, N_DIFF_HEADS, 2, DIFF_QK_DIM)
        ka = ka.reshape(B, S, N_DIFF_HEADS, 2, DIFF_QK_DIM)
        va = va.reshape(B, S, N_DIFF_HEADS, HEAD_DIM)
        qw = qw.reshape(B, S, N_WIN_HEADS, HEAD_DIM)
        kw = kw.reshape(B, S, N_WIN_KV, HEAD_DIM)
        vw = vw.reshape(B, S, N_WIN_KV, HEAD_DIM)
        oa = diff_attention(qa, ka, va, lam, lambda_init, diff_subln_g[l], table_a)
        ow = window_attention(qw, kw, vw, sink_logit[l], table_b)
        x = x + jnp.concatenate([oa, ow], axis=-1) @ w_out[l]
        h2 = rmsnorm(x, norm2_g[l])
        x = x + jnp.square(jax.nn.relu(h2 @ w_ff_in[l])) @ w_ff_out[l]
    return rmsnorm(x, final_norm_g)


def setup_inputs(seed: int = 0) -> dict:
    key = jax.random.key(seed)
    ks = jax.random.split(key, 18)
    f32 = jnp.float32
    nrm = lambda k, shape, s: jax.random.normal(k, shape, f32) * s
    return {
        "x_prompt": nrm(ks[0], (BATCH, SEQ, D_MODEL), 1.0),
        "x_sample": nrm(ks[1], (DEC_BATCH, DEC_SEQ, D_MODEL), 1.0),
        "rel_bias": nrm(ks[2], (N_BUCKETS, N_HEADS_TOTAL), 0.5),
        "norm1_g": 1.0 + nrm(ks[3], (DEPTH, D_MODEL), 0.05),
        "w_in": nrm(ks[4], (DEPTH, D_MODEL, IN_WIDTH), D_MODEL ** -0.5),
        "lambda_q1": nrm(ks[5], (DEPTH, DIFF_QK_DIM), 0.1),
        "lambda_k1": nrm(ks[6], (DEPTH, DIFF_QK_DIM), 0.1),
        "lambda_q2": nrm(ks[7], (DEPTH, DIFF_QK_DIM), 0.1),
        "lambda_k2": nrm(ks[8], (DEPTH, DIFF_QK_DIM), 0.1),
        "diff_subln_g": 1.0 + nrm(ks[9], (DEPTH, HEAD_DIM), 0.05),
        "sink_logit": nrm(ks[10], (DEPTH, N_WIN_HEADS), 0.5),
        "w_out": nrm(ks[11], (DEPTH, MIX_WIDTH, D_MODEL), MIX_WIDTH ** -0.5),
        "norm2_g": 1.0 + nrm(ks[12], (DEPTH, D_MODEL), 0.05),
        "w_ff_in": nrm(ks[13], (DEPTH, D_MODEL, D_FF), D_MODEL ** -0.5),
        "w_ff_out": nrm(ks[14], (DEPTH, D_FF, D_MODEL), D_FF ** -0.5),
        "final_norm_g": 1.0 + nrm(ks[15], (D_MODEL,), 0.05),
    }


def reference(x_prompt, x_sample, rel_bias, norm1_g, w_in, lambda_q1, lambda_k1, lambda_q2,
              lambda_k2, diff_subln_g, sink_logit, w_out, norm2_g, w_ff_in, w_ff_out, final_norm_g):
    y_prompt = trunk(x_prompt, rel_bias, norm1_g, w_in, lambda_q1, lambda_k1, lambda_q2, lambda_k2,
                     diff_subln_g, sink_logit, w_out, norm2_g, w_ff_in, w_ff_out, final_norm_g)
    y_sample = trunk(x_sample, rel_bias, norm1_g, w_in, lambda_q1, lambda_k1, lambda_q2, lambda_k2,
                     diff_subln_g, sink_logit, w_out, norm2_g, w_ff_in, w_ff_out, final_norm_g)
    return (y_prompt, y_sample)
```

```cpp
#include <hip/hip_runtime.h>
#include <hip/hip_bf16.h>
#include <hip/hip_cooperative_groups.h>
#include <cstdio>
#include <cstdint>
namespace cg = cooperative_groups;

#ifndef MK_MULTI
#define MK_MULTI 0
#endif


namespace pg8 {
#define PG8_LAS __attribute__((address_space(3)))
typedef unsigned short bf16_t;
typedef short bf16x8 __attribute__((ext_vector_type(8)));
typedef float f32x4 __attribute__((ext_vector_type(4)));
typedef unsigned u32x4 __attribute__((ext_vector_type(4)));
constexpr int BM = 256, BK = 64, HALF = 128, HTB = HALF * BK * 2  , STAGE_BYTES = 8 * HTB, NXCD = 8, WGM = 4;

__host__ __device__ __forceinline__ int lds_byte(int r, int c) { const int st = (r >> 4) * 2 + (c >> 5), rr = r & 15, cc = c & 31, ob = rr * 64 + cc * 2; return st * 1024 + (ob ^ (((ob >> 9) & 1) << 5)); }
__host__ __device__ __forceinline__ void stage_rc(int b, int& R, int& C) { const int st = b / 1024, sb = b % 1024, swz = sb ^ (((sb >> 9) & 1) << 5); R = (st >> 1) * 16 + swz / 64; C = (st & 1) * 32 + (swz % 64) / 2; }
__host__ __device__ __forceinline__ int perm32(int rho) { const int n = rho >> 4, i = rho & 15; return 8 * (i >> 2) + 4 * n + (i & 3); }

struct Unit { int pm, pn; };
struct Gemm { const bf16_t* A; const bf16_t* Bt; int M, N, K; };

struct StaticOrder {
    int nM, nN, nwg, G, c;
    __host__ __device__ void init(int M, int N, int G_, int c_) { nM = M / BM; nN = N / BM; nwg = nM * nN; G = G_; c = c_; }
    __host__ __device__ bool next(int i, Unit& u) const {
        const long L = (long)i * G + c; if (L >= nwg) return false;
        int wgid = (int)L; { const int q = nwg / NXCD, r = nwg % NXCD, xcd = wgid % NXCD, off = wgid / NXCD; wgid = (xcd < r ? xcd * (q + 1) : r * (q + 1) + (xcd - r) * q) + off; }
        const int nig = WGM * nN, gid = wgid / nig, fm = gid * WGM, gsz = (nM - fm) < WGM ? (nM - fm) : WGM;
        u.pm = fm + ((wgid % nig) % gsz); u.pn = (wgid % nig) / gsz; return true;
    }
    __device__ __forceinline__ void a_ready(const Unit&) const {}
    __device__ __forceinline__ void done(const Unit&) const {}
};

typedef unsigned u32x4 __attribute__((ext_vector_type(4)));
__device__ __forceinline__ unsigned cvt_pk_bf16(float lo, float hi) { unsigned r; asm volatile("v_cvt_pk_bf16_f32 %0, %1, %2" : "=v"(r) : "v"(lo), "v"(hi)); return r; }

template <int ACT  > struct EpiBf16 {
    static constexpr bool PERM = true, AFTER_DRAIN = false;
    bf16_t* O; int ldc; const float* ssq;
    __device__ __forceinline__ void operator()(const f32x4 (&acc)[2][2][4][2], const Unit& u, int wr, int wc, int fr, int fq) const {
        asm volatile("" : "+v"(fr), "+v"(fq));
        const int row0 = u.pm * BM + wr * 64 + fr; const int col0 = u.pn * BM + wc * 32 + 8 * fq;
#pragma unroll
        for (int ai = 0; ai < 2; ++ai)
#pragma unroll
            for (int m = 0; m < 4; ++m) { const int row = row0 + ai * HALF + m * 16; bf16_t* rowp = O + (size_t)row * ldc + col0;
                const float rs = __builtin_amdgcn_rsqf(ssq[row] * (1.f / 2048.f) + 1e-6f);
#pragma unroll
                for (int bj = 0; bj < 2; ++bj) { f32x4 v0 = acc[ai][bj][m][0] * rs, v1 = acc[ai][bj][m][1] * rs;
                    if (ACT == 1) {
#pragma unroll
                        for (int e = 0; e < 4; ++e) { float a = fmaxf(v0[e], 0.f), b = fmaxf(v1[e], 0.f); v0[e] = a * a; v1[e] = b * b; } }
                    u32x4 w; w.x = cvt_pk_bf16(v0[0], v0[1]); w.y = cvt_pk_bf16(v0[2], v0[3]); w.z = cvt_pk_bf16(v1[0], v1[1]); w.w = cvt_pk_bf16(v1[2], v1[3]);
                    *(u32x4*)(rowp + bj * HALF) = w; } }
    }
};
struct EpiResF32 {
    static constexpr bool PERM = true, AFTER_DRAIN = false;
    const float* b0; const float* b1; int split; float* out; bf16_t* xn; const float* g; float* ssq;
    __device__ __forceinline__ void operator()(const f32x4 (&acc)[2][2][4][2], const Unit& u, int wr, int wc, int fr, int fq) const {
        asm volatile("" : "+v"(fr), "+v"(fq));
        const int col0 = u.pn * BM + wc * 32 + 8 * fq;
        const int rt = u.pm * BM; const float* bb = (rt < split) ? b0 + (size_t)rt * 2048 : b1 + (size_t)(rt - split) * 2048; float* oo = out + (size_t)rt * 2048; bf16_t* xx = xn + (size_t)rt * 2048;
#pragma unroll
        for (int ai = 0; ai < 2; ++ai)
#pragma unroll
            for (int m = 0; m < 4; ++m) { const int rl = ai * HALF + wr * 64 + m * 16 + fr; const size_t off = (size_t)rl * 2048 + col0; float s = 0.f;
#pragma unroll
                for (int bj = 0; bj < 2; ++bj) {
                    const f32x4 v0 = *(const f32x4*)(bb + off + bj * HALF) + acc[ai][bj][m][0], v1 = *(const f32x4*)(bb + off + bj * HALF + 4) + acc[ai][bj][m][1];
                    *(f32x4*)(oo + off + bj * HALF) = v0; *(f32x4*)(oo + off + bj * HALF + 4) = v1;
                    s += (v0[0] * v0[0] + v0[1] * v0[1]) + (v0[2] * v0[2] + v0[3] * v0[3]) + (v1[0] * v1[0] + v1[1] * v1[1]) + (v1[2] * v1[2] + v1[3] * v1[3]);
                    const f32x4 a = v0 * *(const f32x4*)(g + col0 + bj * HALF), b = v1 * *(const f32x4*)(g + col0 + bj * HALF + 4);
                    u32x4 w; w.x = cvt_pk_bf16(a[0], a[1]); w.y = cvt_pk_bf16(a[2], a[3]); w.z = cvt_pk_bf16(b[0], b[1]); w.w = cvt_pk_bf16(b[2], b[3]);
                    if (xn) *(u32x4*)(xx + off + bj * HALF) = w; }
                s += __shfl_xor(s, 16); s += __shfl_xor(s, 32);
                if (fq == 0) atomicAdd(ssq + rt + rl, s); }
    }
};
template <class Epi, class Sched, bool ALIGN_EPI = false, bool SP2 = false>
__device__ __forceinline__ void gemm_phase(PG8_LAS unsigned char* lds, const Gemm g, const Sched& S, const Epi& E) {
    int tid_ = threadIdx.x; asm volatile("" : "+v"(tid_));
    const int tid = tid_, wid = __builtin_amdgcn_readfirstlane(tid >> 6), lane = tid & 63, wr = wid >> 2, wc = wid & 3, fr = lane & 15, fq = lane >> 4;
    const int K = g.K, nt = K / BK;
    unsigned voffA[2], voffB[2];
#pragma unroll
    for (int i = 0; i < 2; ++i) { int R, C; stage_rc(tid * 16 + i * 8192, R, C); const int Rb = Epi::PERM ? ((R & ~31) + perm32(R & 31)) : R;
        voffA[i] = (unsigned)(R * K + C) * 2u; voffB[i] = (unsigned)(Rb * K + C) * 2u; }
    const size_t kstep = (size_t)(BK * 2);
    const size_t hstep = (size_t)HALF * K * 2;
    const size_t tstep = 2 * hstep;
    const unsigned ldsw = (unsigned)wid * 1024u;
    const int aoff = lds_byte(wr * 64 + fr, fq * 8), boff = lds_byte(wc * 32 + fr, fq * 8);
#define PG8_SA(b, h) (((b) * 2 + (h)) * HTB)
#define PG8_SB(b, h) ((4 + (b) * 2 + (h)) * HTB)
#define PG8_STAGE(bufoff, gbase, voff) do { _Pragma("unroll") for (int _i = 0; _i < 2; ++_i) \
        __builtin_amdgcn_global_load_lds((const unsigned*)((const char*)(gbase) + (voff)[_i]), (PG8_LAS unsigned*)(lds + (bufoff) + ldsw + _i * 8192), 16, 0, 0); } while (0)
#define PG8_LDA(dst, b, h) do { _Pragma("unroll") for (int m = 0; m < 4; ++m) _Pragma("unroll") for (int k = 0; k < 2; ++k) dst[m][k] = *(const PG8_LAS bf16x8*)(lds + PG8_SA(b, h) + aoff + m * 2048 + k * 1024); } while (0)
#define PG8_LDB(dst, b, h) do { _Pragma("unroll") for (int n = 0; n < 2; ++n) _Pragma("unroll") for (int k = 0; k < 2; ++k) dst[n][k] = *(const PG8_LAS bf16x8*)(lds + PG8_SB(b, h) + boff + n * 2048 + k * 1024); } while (0)
#define PG8_MMA(ai, bj, At, Bt) do { __builtin_amdgcn_s_setprio(1); _Pragma("unroll") for (int m = 0; m < 4; ++m) _Pragma("unroll") for (int n = 0; n < 2; ++n) _Pragma("unroll") for (int k = 0; k < 2; ++k) \
        acc[ai][bj][m][n] = __builtin_amdgcn_mfma_f32_16x16x32_bf16(Bt[n][k], At[m][k], acc[ai][bj][m][n], 0, 0, 0); __builtin_amdgcn_s_setprio(0); } while (0)
#define PG8_WAIT_V(n) asm volatile("s_waitcnt vmcnt(" #n ")" ::: "memory")
#define PG8_WAIT_L(n) asm volatile("s_waitcnt lgkmcnt(" #n ")" ::: "memory")
#define PG8_BAR __builtin_amdgcn_s_barrier()
#define PG8_SCHED __builtin_amdgcn_sched_barrier(0)
    Unit cur, nxt; int ui = 0;
    if (!S.next(0, cur)) return;
    f32x4 acc[2][2][4][2];
#pragma unroll
    for (int a = 0; a < 2; ++a)
#pragma unroll
        for (int b = 0; b < 2; ++b)
#pragma unroll
            for (int m = 0; m < 4; ++m)
#pragma unroll
                for (int n = 0; n < 2; ++n) acc[a][b][m][n] = (f32x4){0.f, 0.f, 0.f, 0.f};
    bf16x8 At[4][2], B0[2][2], B1[2][2];
    const char* cA = (const char*)g.A + (size_t)cur.pm * tstep; const char* cB = (const char*)g.Bt + (size_t)cur.pn * tstep;
    S.a_ready(cur);
    if constexpr (SP2) {
        PG8_STAGE(PG8_SB(0, 0), cB, voffB); PG8_STAGE(PG8_SB(0, 1), cB + hstep, voffB); PG8_STAGE(PG8_SA(0, 0), cA, voffA); PG8_STAGE(PG8_SA(0, 1), cA + hstep, voffA);
        if (wr == 1) PG8_BAR;
        PG8_WAIT_V(2); PG8_BAR;
        PG8_STAGE(PG8_SB(1, 0), cB + kstep, voffB); PG8_STAGE(PG8_SA(1, 0), cA + kstep, voffA); PG8_STAGE(PG8_SB(1, 1), cB + hstep + kstep, voffB);
        PG8_WAIT_V(6); PG8_BAR;
    } else {
        PG8_STAGE(PG8_SB(0, 0), cB, voffB); PG8_STAGE(PG8_SA(0, 0), cA, voffA); PG8_STAGE(PG8_SB(0, 1), cB + hstep, voffB); PG8_STAGE(PG8_SA(0, 1), cA + hstep, voffA);
        if (wr == 1) PG8_BAR;
        PG8_WAIT_V(4); PG8_BAR;
        PG8_STAGE(PG8_SB(1, 0), cB + kstep, voffB); PG8_STAGE(PG8_SA(1, 0), cA + kstep, voffA); PG8_STAGE(PG8_SB(1, 1), cB + hstep + kstep, voffB);
        PG8_WAIT_V(6); PG8_BAR;
    }
    for (;;) {
        const bool has_next = S.next(ui + 1, nxt);
        const char* nA = has_next ? (const char*)g.A + (size_t)nxt.pm * tstep : cA; const char* nB = has_next ? (const char*)g.Bt + (size_t)nxt.pn * tstep : cB;
        for (int t = 0; t < nt; t += 2) {
            const bool last = (t == nt - 2);
            const char* a1 = cA + (size_t)(t + 1) * kstep;
            const char* a2 = last ? nA : cA + (size_t)(t + 2) * kstep; const char* b2 = last ? nB : cB + (size_t)(t + 2) * kstep;
            const char* a3 = a2 + kstep; const char* b3 = b2 + kstep;
            if (last && has_next) S.a_ready(nxt);
            if constexpr (SP2) {
            PG8_LDB(B0, 0, 0); PG8_LDB(B1, 0, 1); PG8_SCHED; PG8_LDA(At, 0, 0); PG8_STAGE(PG8_SA(1, 1), a1 + hstep, voffA);
            PG8_WAIT_V(8); PG8_WAIT_L(0); PG8_BAR; PG8_MMA(0, 0, At, B0); PG8_MMA(0, 1, At, B1); PG8_BAR; PG8_SCHED;
            PG8_LDA(At, 0, 1); PG8_STAGE(PG8_SB(0, 0), b2, voffB); PG8_STAGE(PG8_SB(0, 1), b2 + hstep, voffB); PG8_STAGE(PG8_SA(0, 0), a2, voffA);
            PG8_WAIT_V(8); PG8_WAIT_L(0); PG8_BAR; PG8_MMA(1, 0, At, B0); PG8_MMA(1, 1, At, B1); PG8_BAR; PG8_SCHED;
            PG8_LDB(B0, 1, 0); PG8_LDB(B1, 1, 1); PG8_SCHED; PG8_LDA(At, 1, 0); PG8_STAGE(PG8_SA(0, 1), a2 + hstep, voffA);
            PG8_WAIT_V(8); PG8_WAIT_L(0); PG8_BAR; PG8_MMA(0, 0, At, B0); PG8_MMA(0, 1, At, B1); PG8_BAR; PG8_SCHED;
            PG8_LDA(At, 1, 1); PG8_STAGE(PG8_SB(1, 0), b3, voffB); PG8_STAGE(PG8_SB(1, 1), b3 + hstep, voffB); PG8_STAGE(PG8_SA(1, 0), a3, voffA);
            PG8_WAIT_V(8); PG8_WAIT_L(0); PG8_BAR; PG8_MMA(1, 0, At, B0); PG8_MMA(1, 1, At, B1); PG8_BAR; PG8_SCHED;
            } else {
            PG8_LDB(B0, 0, 0); PG8_SCHED; PG8_LDA(At, 0, 0); PG8_STAGE(PG8_SA(1, 1), a1 + hstep, voffA);
            PG8_WAIT_L(8); PG8_BAR; PG8_WAIT_L(0); PG8_MMA(0, 0, At, B0); PG8_BAR; PG8_SCHED;
            PG8_LDB(B1, 0, 1); PG8_STAGE(PG8_SB(0, 0), b2, voffB);
            PG8_BAR; PG8_WAIT_L(0); PG8_MMA(0, 1, At, B1); PG8_BAR;
            PG8_LDA(At, 0, 1); PG8_STAGE(PG8_SA(0, 0), a2, voffA);
            PG8_BAR; PG8_WAIT_L(0); PG8_MMA(1, 0, At, B0); PG8_BAR; PG8_SCHED;
            PG8_STAGE(PG8_SB(0, 1), b2 + hstep, voffB);
            PG8_WAIT_V(6); PG8_BAR; PG8_MMA(1, 1, At, B1); PG8_BAR;
            PG8_LDB(B0, 1, 0); PG8_SCHED; PG8_LDA(At, 1, 0); PG8_STAGE(PG8_SA(0, 1), a2 + hstep, voffA);
            PG8_WAIT_L(8); PG8_BAR; PG8_WAIT_L(0); PG8_MMA(0, 0, At, B0); PG8_BAR; PG8_SCHED;
            PG8_LDB(B1, 1, 1); PG8_STAGE(PG8_SB(1, 0), b3, voffB);
            PG8_BAR; PG8_WAIT_L(0); PG8_MMA(0, 1, At, B1); PG8_BAR;
            PG8_LDA(At, 1, 1); PG8_STAGE(PG8_SA(1, 0), a3, voffA);
            PG8_BAR; PG8_WAIT_L(0); PG8_MMA(1, 0, At, B0); PG8_BAR; PG8_SCHED;
            PG8_STAGE(PG8_SB(1, 1), b3 + hstep, voffB);
            PG8_WAIT_V(6); PG8_BAR; PG8_MMA(1, 1, At, B1); PG8_BAR;
            }
        }
        if constexpr (ALIGN_EPI) { if (wr == 0) PG8_BAR; }
        if constexpr (!Epi::AFTER_DRAIN) { E(acc, cur, wr, wc, fr, fq); S.done(cur); }
        if (!has_next) break;
#pragma unroll
        for (int a = 0; a < 2; ++a)
#pragma unroll
            for (int b = 0; b < 2; ++b)
#pragma unroll
                for (int m = 0; m < 4; ++m)
#pragma unroll
                    for (int n = 0; n < 2; ++n) acc[a][b][m][n] = (f32x4){0.f, 0.f, 0.f, 0.f};
        cur = nxt; cA = nA; cB = nB; ++ui;
        if constexpr (ALIGN_EPI) { if (wr == 1) PG8_BAR; }
    }
    PG8_WAIT_V(0);
    if constexpr (!ALIGN_EPI) { if (wr == 0) PG8_BAR; }
    PG8_BAR;
    if constexpr (Epi::AFTER_DRAIN) { E.fused(acc, cur, wr, wc, fr, fq, lds, wid, lane); S.done(cur); }
#undef PG8_SA
#undef PG8_SB
#undef PG8_STAGE
#undef PG8_LDA
#undef PG8_LDB
#undef PG8_MMA
#undef PG8_WAIT_V
#undef PG8_WAIT_L
#undef PG8_BAR
#undef PG8_SCHED
}
}
namespace att {
using bf16 = unsigned short;
using bf16x8 = __attribute__((ext_vector_type(8))) short;
using s16x4  = __attribute__((ext_vector_type(4))) short;
using f32x16 = __attribute__((ext_vector_type(16))) float;
using u32x4  = __attribute__((ext_vector_type(4))) unsigned;
constexpr int KVBLK = 64, LDP = 4608, LDO = 2048;
constexpr int SHM_V = 16384, SHM_K = 16384;
constexpr int SLOT = SHM_V + SHM_K, NSLOT = 3;
constexpr int OFF_V = 0, OFF_K = SHM_V, OFF_WS = NSLOT * SLOT, OFF_TAB = OFF_WS + 8 * 64 * 4, ATT_LDS = OFF_TAB + 272 * 4;
constexpr float LOG2E = 1.4426950408889634f;
constexpr float THR = 8.f;
constexpr float NEGB = -1e30f;
#define KSWZ(row, colB) ((row) * 256 + ((colB) ^ (((row) & 7) << 4)))
#define SBAR() __builtin_amdgcn_sched_barrier(0)
__device__ __forceinline__ int crow(int r, int hi) { return (r & 3) + 8 * (r >> 2) + 4 * hi; }
__device__ __forceinline__ unsigned cvtpk(float lo, float hi) { unsigned r; asm volatile("v_cvt_pk_bf16_f32 %0, %1, %2" : "=v"(r) : "v"(lo), "v"(hi)); return r; }
__device__ __forceinline__ bf16x8 ld8(const bf16* p) { return *reinterpret_cast<const bf16x8*>(p); }

__device__ __forceinline__ int t5_bucket(int rel) {
  const int n = rel < 0 ? -rel : rel; int b;
  if (n < 8) b = n; else { int l = (31 - __builtin_clz((unsigned)(n * n))) - 6; b = 8 + l; if (b > 15) b = 15; }
  return (rel > 0 ? 16 : 0) + b;
}

__device__ __forceinline__ float max3f(float a, float b, float c) { float r; asm("v_max3_f32 %0, %1, %2, %3" : "=v"(r) : "v"(a), "v"(b), "v"(c)); return r; }
__device__ __forceinline__ void partialSM(f32x16& p0, f32x16& p1, float& m_reg, float& alpha, float Ce, float be) {
  float pmax = max3f(p0[0], p0[1], p1[0]), pmb = max3f(p0[2], p0[3], p1[1]);
  pmax = max3f(pmax, p1[2], p1[3]);
#pragma unroll
  for (int r = 4; r < 16; r += 4) { pmax = max3f(pmax, p0[r], p0[r + 1]); pmb = max3f(pmb, p0[r + 2], p0[r + 3]); pmax = max3f(pmax, p1[r], p1[r + 1]); pmb = max3f(pmb, p1[r + 2], p1[r + 3]); }
  pmax = max3f(pmax, pmb, pmb);
  { auto rr = __builtin_amdgcn_permlane32_swap(__float_as_uint(pmax), __float_as_uint(pmax), false, false);
    pmax = fmaxf(__uint_as_float(rr[0]), __uint_as_float(rr[1])); }
  pmax = fmaf(pmax, Ce, be);
  float mn;
  if (__builtin_expect(__all(pmax - m_reg <= THR), 1)) { mn = m_reg; alpha = 1.f; }
  else { mn = fmaxf(m_reg, pmax); alpha = __builtin_amdgcn_exp2f(m_reg - mn); m_reg = mn; }
  const float off = be - mn;
#pragma unroll
  for (int r = 0; r < 16; ++r) p0[r] = fmaf(p0[r], Ce, off);
#pragma unroll
  for (int r = 0; r < 16; ++r) p1[r] = fmaf(p1[r], Ce, off);
#pragma unroll
  for (int r = 0; r < 16; ++r) p0[r] = __builtin_amdgcn_exp2f(p0[r]);
}
__device__ __forceinline__ void finishSM(f32x16& p0, f32x16& p1, float alpha, float& l_reg, bf16x8& pa0, bf16x8& pa1, bf16x8& pa2, bf16x8& pa3) {
#pragma unroll
  for (int r = 0; r < 16; ++r) p1[r] = __builtin_amdgcn_exp2f(p1[r]);
  float ps = 0;
#pragma unroll
  for (int r = 0; r < 16; ++r) ps += p0[r];
#pragma unroll
  for (int r = 0; r < 16; ++r) ps += p1[r];
  { auto rr = __builtin_amdgcn_permlane32_swap(__float_as_uint(ps), __float_as_uint(ps), false, false);
    ps = __uint_as_float(rr[0]) + __uint_as_float(rr[1]); }
  l_reg = l_reg * alpha + ps;
#define PK4(P, BASE, OUT) do { unsigned a0 = cvtpk(P[BASE + 0], P[BASE + 1]), a1 = cvtpk(P[BASE + 2], P[BASE + 3]);   \
    unsigned b0 = cvtpk(P[BASE + 4], P[BASE + 5]), b1 = cvtpk(P[BASE + 6], P[BASE + 7]);                              \
    auto r0 = __builtin_amdgcn_permlane32_swap(a0, b0, false, false); auto r1 = __builtin_amdgcn_permlane32_swap(a1, b1, false, false); \
    u32x4 w = {r0[0], r1[0], r0[1], r1[1]}; OUT = *reinterpret_cast<bf16x8*>(&w); } while (0)
  PK4(p0, 0, pa0); PK4(p0, 8, pa1); PK4(p1, 0, pa2); PK4(p1, 8, pa3);
#undef PK4
}
__device__ __forceinline__ bf16x8 scale_bf16x8(bf16x8 v, float c) {
  u32x4 w = *reinterpret_cast<u32x4*>(&v), o;
#pragma unroll
  for (int i = 0; i < 4; ++i) { const float lo = __uint_as_float(w[i] << 16), hh = __uint_as_float(w[i] & 0xffff0000u); o[i] = cvtpk(lo * c, hh * c); }
  return *reinterpret_cast<bf16x8*>(&o);
}
template <int ND0> __device__ __forceinline__ void qkt(f32x16& p0, f32x16& p1, const char* Ks, const bf16x8* qr, int r32, int hi, int cboff, const f32x16& ci) {
#pragma unroll
  for (int d0 = 0; d0 < ND0; ++d0) { int cb = cboff + (d0 * 16 + hi * 8) * 2;
    bf16x8 b0 = *reinterpret_cast<const bf16x8*>(Ks + KSWZ(r32, cb));
    bf16x8 b1 = *reinterpret_cast<const bf16x8*>(Ks + KSWZ(32 + r32, cb));
    if (d0 == 0) { p0 = __builtin_amdgcn_mfma_f32_32x32x16_bf16(b0, qr[0], ci, 0, 0, 0); p1 = __builtin_amdgcn_mfma_f32_32x32x16_bf16(b1, qr[0], ci, 0, 0, 0); }
    else { p0 = __builtin_amdgcn_mfma_f32_32x32x16_bf16(b0, qr[d0], p0, 0, 0, 0); p1 = __builtin_amdgcn_mfma_f32_32x32x16_bf16(b1, qr[d0], p1, 0, 0, 0); } }
}
template <bool FIRST> __device__ __forceinline__ void partialSM2(f32x16& p0, f32x16& p1, float& m_ref, f32x16& negm, float& alpha) {
  float pmax = max3f(p0[0], p0[1], p1[0]), pmb = max3f(p0[2], p0[3], p1[1]);
  pmax = max3f(pmax, p1[2], p1[3]);
#pragma unroll
  for (int r = 4; r < 16; r += 4) { pmax = max3f(pmax, p0[r], p0[r + 1]); pmb = max3f(pmb, p0[r + 2], p0[r + 3]); pmax = max3f(pmax, p1[r], p1[r + 1]); pmb = max3f(pmb, p1[r + 2], p1[r + 3]); }
  pmax = max3f(pmax, pmb, pmb);
  { auto rr = __builtin_amdgcn_permlane32_swap(__float_as_uint(pmax), __float_as_uint(pmax), false, false);
    pmax = fmaxf(__uint_as_float(rr[0]), __uint_as_float(rr[1])); }
  alpha = 1.f;
  if (FIRST || !__builtin_expect(__all(pmax <= THR), 1)) {
    const float dl = FIRST ? pmax : fmaxf(pmax, 0.f); m_ref += dl; if (!FIRST) alpha = __builtin_amdgcn_exp2f(-dl);
#pragma unroll
    for (int r = 0; r < 16; ++r) { p0[r] -= dl; p1[r] -= dl; negm[r] -= dl; }
  }
#pragma unroll
  for (int r = 0; r < 16; ++r) p0[r] = __builtin_amdgcn_exp2f(p0[r]);
}
__device__ __forceinline__ int v_st(int k, int c) { const int kk = (k & ~0xC) | ((k & 4) << 1) | ((k & 8) >> 1); return ((kk >> 3) * 4 + (c >> 5)) * 512 + ((kk & 7) * 32 + (c & 31)) * 2; }
__device__ __forceinline__ int v_rd_base(int lane) { return ((lane & 3) << 3) | (((lane >> 2) & 3) << 6) | (((lane >> 4) & 1) << 5) | (((lane >> 5) & 1) << 8); }
constexpr int v_rd_off(int d0, int ks, int half) { return d0 * 512 + ks * 4096 + half * 2048; }
template <int OFF> __device__ __forceinline__ s16x4 tr_read(int vb) {
  s16x4 r; asm volatile("ds_read_b64_tr_b16 %0, %1 offset:%2" : "=&v"(r) : "v"(vb), "i"(OFF) : "memory"); return r;
}
#define VRD8(D0, L0, H0, L1, H1, L2, H2, L3, H3) do { L0 = tr_read<v_rd_off(D0, 0, 0)>(vb); H0 = tr_read<v_rd_off(D0, 0, 1)>(vb); L1 = tr_read<v_rd_off(D0, 1, 0)>(vb); H1 = tr_read<v_rd_off(D0, 1, 1)>(vb); \
    L2 = tr_read<v_rd_off(D0, 2, 0)>(vb); H2 = tr_read<v_rd_off(D0, 2, 1)>(vb); L3 = tr_read<v_rd_off(D0, 3, 0)>(vb); H3 = tr_read<v_rd_off(D0, 3, 1)>(vb); } while (0)
#define PK(L, H) (bf16x8){L[0], L[1], L[2], L[3], H[0], H[1], H[2], H[3]}
#define MMA4(OD, L0, H0, L1, H1, L2, H2, L3, H3) do { OD = __builtin_amdgcn_mfma_f32_32x32x16_bf16(pa0, PK(L0, H0), OD, 0, 0, 0); OD = __builtin_amdgcn_mfma_f32_32x32x16_bf16(pa1, PK(L1, H1), OD, 0, 0, 0); \
    OD = __builtin_amdgcn_mfma_f32_32x32x16_bf16(pa2, PK(L2, H2), OD, 0, 0, 0); OD = __builtin_amdgcn_mfma_f32_32x32x16_bf16(pa3, PK(L3, H3), OD, 0, 0, 0); } while (0)
__device__ __forceinline__ void pv_d0(f32x16* o, int vb, bf16x8 pa0, bf16x8 pa1, bf16x8 pa2, bf16x8 pa3) {
  s16x4 a0, a1, a2, a3, a4, a5, a6, a7, b0, b1, b2, b3, b4, b5, b6, b7;
  VRD8(0, a0, a1, a2, a3, a4, a5, a6, a7);
  VRD8(1, b0, b1, b2, b3, b4, b5, b6, b7);
  asm volatile("s_waitcnt lgkmcnt(8)" ::: "memory"); SBAR();
  MMA4(o[0], a0, a1, a2, a3, a4, a5, a6, a7); SBAR();
  VRD8(2, a0, a1, a2, a3, a4, a5, a6, a7);
  asm volatile("s_waitcnt lgkmcnt(8)" ::: "memory"); SBAR();
  MMA4(o[1], b0, b1, b2, b3, b4, b5, b6, b7); SBAR();
  VRD8(3, b0, b1, b2, b3, b4, b5, b6, b7);
  asm volatile("s_waitcnt lgkmcnt(8)" ::: "memory"); SBAR();
  MMA4(o[2], a0, a1, a2, a3, a4, a5, a6, a7); SBAR();
  asm volatile("s_waitcnt lgkmcnt(0)" ::: "memory"); SBAR();
  MMA4(o[3], b0, b1, b2, b3, b4, b5, b6, b7);
}
#undef VRD8
#undef PK
#undef MMA4

template <int MODE, int ORD>
__device__ __forceinline__ void attn_unit(const bf16* __restrict__ Qb, const bf16* __restrict__ Kh, const bf16* __restrict__ Vh, bf16* __restrict__ Ob,
                                          int qpos0, int kbeg, int NT, const float* __restrict__ tabsrc, float sinkv, float lam, float oscale,
                                          const float* __restrict__ subg, char* lds) {
  constexpr int ND0 = MODE == 0 ? 4 : 8;
  const float C = (MODE == 0 ? 0.125f : 0.08838834764831845f) * LOG2E;
  int tid_ = threadIdx.x; asm volatile("" : "+v"(tid_));
  const int tid = tid_, wid = __builtin_amdgcn_readfirstlane(tid >> 6), lane = tid & 63; int r32 = lane & 31, hi = lane >> 5;
  const int wq = MODE == 0 ? (wid & 3) : wid, cst = MODE == 0 ? (wid >> 2) : 0;
  char* V_lds = lds + OFF_V; char* K_lds = lds + OFF_K;
  float* wsf = (float*)(lds + OFF_WS) + wid * 64; float* li_l = wsf; float* al_l = wsf + 32;
  float* tab = (float*)(lds + OFF_TAB);
  __syncthreads();
  if (wid >= 4) __builtin_amdgcn_s_setprio(1);
  if (tid < 257) tab[tid] = tabsrc[t5_bucket(tid - 128) * 16] * LOG2E;
  float m_reg = MODE == 0 ? 0.f : sinkv * LOG2E, l_reg = MODE == 0 ? 0.f : 1.f;
  f32x16 o[4] = {}; bf16x8 qr[ND0];
  const bf16* Qw = Qb + (long)(wq * 32 + r32) * LDP + cst * 64 + hi * 8;
#pragma unroll
  for (int d0 = 0; d0 < ND0; ++d0) qr[d0] = scale_bf16x8(ld8(Qw + d0 * 16), C);
  const int qpos = qpos0 + wq * 32 + r32;
  const int qw0 = qpos0 + wq * 32;
  const int cboff = cst * 128;
  int sr = tid >> 4, sc = (tid & 15) * 8, vst0 = v_st(sr, sc), vst1 = v_st(32 + sr, sc);
  int vb0 = (int)(uintptr_t)V_lds + v_rd_base(lane);
  const bf16* Kg = Kh + (long)kbeg * LDP; const bf16* Vg = Vh + (long)kbeg * LDP;
  struct { bf16x8 vs0, vs1, ks0, ks1; } sr_[1];
#define SLOAD(i, k0) do { sr_[i].vs0 = ld8(&Vg[(long)((k0) + sr) * LDP + sc]); sr_[i].vs1 = ld8(&Vg[(long)((k0) + 32 + sr) * LDP + sc]); \
    sr_[i].ks0 = ld8(&Kg[(long)((k0) + sr) * LDP + sc]); sr_[i].ks1 = ld8(&Kg[(long)((k0) + 32 + sr) * LDP + sc]); } while (0)
#define SWRITE(off, i) do { *(bf16x8*)(V_lds + (off) + vst0) = sr_[i].vs0;          \
    *(bf16x8*)(V_lds + (off) + vst1) = sr_[i].vs1; int kc = sc * 2;               \
    *(bf16x8*)(K_lds + (off) + KSWZ(sr, kc)) = sr_[i].ks0;                       \
    *(bf16x8*)(K_lds + (off) + KSWZ(32 + sr, kc)) = sr_[i].ks1; } while (0)
#define SWAIT() asm volatile("s_waitcnt vmcnt(0)" ::: "memory")
#define RESC(a) do { if (__any((a) < 1.f)) { if (hi == 0) al_l[r32] = (a); asm volatile("s_waitcnt lgkmcnt(0)" ::: "memory"); \
    _Pragma("unroll") for (int d = 0; d < 4; ++d) _Pragma("unroll") for (int r = 0; r < 16; ++r) o[d][r] *= al_l[crow(r, hi)]; } } while (0)
  float bL, bR, be_cur = 0.f; f32x16 negm;
#pragma unroll
  for (int r = 0; r < 16; ++r) negm[r] = -m_reg;
#define TCLS(t) const int k0_ = kbeg + (t) * KVBLK; const int rmax_ = k0_ + 63 - qw0, rmin_ = k0_ - qw0 - 31; const bool near_ = (MODE == 1) || (rmax_ > -128 && rmin_ < 128)
#define SETBE(t) do { TCLS(t); const float bt_ = near_ ? 0.f : ((rmax_ <= -128) ? bL : bR); \
    if (bt_ != be_cur) { const float d_ = bt_ - be_cur; _Pragma("unroll") for (int r = 0; r < 16; ++r) negm[r] += d_; be_cur = bt_; } } while (0)
#define BIAS(P0, P1, t) do { TCLS(t); (void)rmin_; (void)rmax_; \
    if (near_) { asm volatile("" ::: "memory");     \
      const int base_ = k0_ - qpos + 128 + 4 * hi; \
      _Pragma("unroll") for (int r = 0; r < 16; ++r) { const int i0 = base_ + (r & 3) + 8 * (r >> 2), i1 = i0 + 32; \
        const int c0 = i0 < 0 ? 0 : (i0 > 256 ? 256 : i0), c1 = i1 < 0 ? 0 : (i1 > 256 ? 256 : i1); \
        const float t0 = P0[r] + tab[c0], t1 = P1[r] + tab[c1]; \
        if (MODE == 1) { P0[r] = (i0 == c0) ? t0 : NEGB; P1[r] = (i1 == c1) ? t1 : NEGB; } else { P0[r] = t0; P1[r] = t1; } } \
      asm volatile("" ::: "memory"); } } while (0)
  f32x16 pA0, pA1, pB0, pB1; float alA, alB; bf16x8 pa0, pa1, pa2, pa3;
  constexpr int SE = 0, SO = 0;
  SLOAD(SE, 0); asm volatile("s_waitcnt vmcnt(0)" ::: "memory"); SWRITE(0, SE); __syncthreads();
  bL = tab[0]; bR = tab[256];
  SETBE(0); qkt<ND0>(pA0, pA1, K_lds, qr, r32, hi, cboff, negm); BIAS(pA0, pA1, 0); partialSM2<MODE == 0>(pA0, pA1, m_reg, negm, alA);
  SLOAD(SO, KVBLK);
  SWAIT(); SWRITE(SLOT, SO); __syncthreads();
  int op = 0, oc = SLOT, on = 2 * SLOT;
#define ROT() do { const int t_ = op; op = oc; oc = on; on = t_; } while (0)
#define TILE_STEP1(PN0, PN1, ALN, PO0, PO1, ALO, TN, LOADS) do { \
      SBAR(); finishSM(PO0, PO1, ALO, l_reg, pa0, pa1, pa2, pa3); SBAR(); LOADS; SETBE(TN); SBAR(); qkt<ND0>(PN0, PN1, K_lds + oc, qr, r32, hi, cboff, negm); SBAR(); \
      BIAS(PN0, PN1, TN); partialSM2<false>(PN0, PN1, m_reg, negm, ALN); SBAR(); pv_d0(o, vb0 + op, pa0, pa1, pa2, pa3); } while (0)
#define MAIN_LOOP(TS) do { \
  for (int j = 1; j + 1 < NT; j += 2) { \
    TS(pB0, pB1, alB, pA0, pA1, alA, j, SLOAD(SO, (j + 1) * KVBLK)); \
    SWAIT(); SWRITE(on, SE); RESC(alB); __syncthreads(); ROT(); \
    TS(pA0, pA1, alA, pB0, pB1, alB, j + 1, SLOAD(SE, (j + 2) * KVBLK)); \
    SWAIT(); SWRITE(on, SO); RESC(alA); __syncthreads(); ROT(); \
  } \
  TS(pB0, pB1, alB, pA0, pA1, alA, NT - 1, (void)0); } while (0)
  MAIN_LOOP(TILE_STEP1);
#undef MAIN_LOOP
#undef TILE_STEP1
#undef SETBE
#undef TCLS
  RESC(alB);
  finishSM(pB0, pB1, alB, l_reg, pa0, pa1, pa2, pa3); SBAR();
  pv_d0(o, vb0 + oc, pa0, pa1, pa2, pa3);
#undef ROT
  if (hi == 0) li_l[r32] = l_reg; asm volatile("s_waitcnt lgkmcnt(0)" ::: "memory");
  float rli[16];
#pragma unroll
  for (int r = 0; r < 16; ++r) rli[r] = __builtin_amdgcn_rcpf(li_l[crow(r, hi)]);
  if (MODE == 1) {
    bf16* Ow = Ob + (long)(wq * 32) * LDO;
#pragma unroll
    for (int r = 0; r < 16; ++r) { const int orow = crow(r, hi);
#pragma unroll
      for (int d0 = 0; d0 < 4; ++d0) { __hip_bfloat16 bv = __float2bfloat16(o[d0][r] * rli[r]); Ow[(long)orow * LDO + d0 * 32 + r32] = *reinterpret_cast<bf16*>(&bv); } }
  } else {
    __syncthreads();
    float* X = (float*)lds + wq * 4096;
    if (cst == 1) {
#pragma unroll
      for (int r = 0; r < 16; ++r) { const int orow = crow(r, hi);
#pragma unroll
        for (int d0 = 0; d0 < 4; ++d0) X[orow * 128 + d0 * 32 + r32] = o[d0][r] * rli[r]; }
    }
    __syncthreads();
    if (cst == 0) {
      float ssq[16];
#pragma unroll
      for (int r = 0; r < 16; ++r) { const int orow = crow(r, hi); float s = 0.f;
#pragma unroll
        for (int d0 = 0; d0 < 4; ++d0) { const float v = o[d0][r] * rli[r] - lam * X[orow * 128 + d0 * 32 + r32]; o[d0][r] = v; s = fmaf(v, v, s); }
        ssq[r] = s; }
#pragma unroll
      for (int r = 0; r < 16; ++r) {
#pragma unroll
        for (int off = 1; off < 32; off <<= 1) ssq[r] += __shfl_xor(ssq[r], off);
      }
      float gg[4];
#pragma unroll
      for (int d0 = 0; d0 < 4; ++d0) gg[d0] = subg[d0 * 32 + r32] * oscale;
      bf16* Ow = Ob + (long)(wq * 32) * LDO;
#pragma unroll
      for (int r = 0; r < 16; ++r) { const int orow = crow(r, hi); const float rs = __builtin_amdgcn_rsqf(ssq[r] * (1.f / 128.f) + 1e-6f);
#pragma unroll
        for (int d0 = 0; d0 < 4; ++d0) { __hip_bfloat16 bv = __float2bfloat16(o[d0][r] * rs * gg[d0]); Ow[(long)orow * LDO + d0 * 32 + r32] = *reinterpret_cast<bf16*>(&bv); } }
    }
  }
  __builtin_amdgcn_s_setprio(0);
#undef SLOAD
#undef SWRITE
#undef SWAIT
#undef RESC
#undef BIAS
}
#undef SBAR
}

#define LAS __attribute__((address_space(3)))
typedef unsigned short bf16;
typedef unsigned v4u __attribute__((ext_vector_type(4)));
typedef float f32x4 __attribute__((ext_vector_type(4)));
constexpr int NWAVES = 8;
constexpr int DM = 2048, SEQ_P = 8192, NB_P = 4, SEQ_S = 4096, NB_S = 2, DEPTH = 2, DFF = 8192, INW = 4608;
constexpr int M_P = NB_P * SEQ_P, M_S = NB_S * SEQ_S, M = M_P + M_S;
constexpr size_t MiB = 1u << 20;
constexpr size_t WS_WIN = 1 * MiB;
constexpr size_t WS_WOUT = WS_WIN + (size_t)DEPTH * INW * DM * 2;
constexpr size_t WS_WF1 = WS_WOUT + (size_t)DEPTH * DM * DM * 2;
constexpr size_t WS_WF2 = WS_WF1 + (size_t)DEPTH * DFF * DM * 2;
constexpr size_t WS_XN = WS_WF2 + (size_t)DEPTH * DM * DFF * 2;
constexpr size_t WS_H = WS_XN + (size_t)M * DM * 2;
constexpr size_t WS_PROJ = WS_H;
constexpr size_t WS_ATT = WS_PROJ + (size_t)M * INW * 2;
constexpr size_t WS_END = WS_H + (size_t)M * DFF * 2;
static_assert(WS_ATT + (size_t)M * DM * 2 <= WS_END, "overlay");
constexpr int LDS_BYTES = 147456;
static_assert(att::ATT_LDS <= 131072, "attention LDS");

__device__ __forceinline__ unsigned f2bf(float f) { unsigned u = __builtin_bit_cast(unsigned, f); return (u + 0x7fffu + ((u >> 16) & 1u)) >> 16; }
__device__ __forceinline__ unsigned pk2(float lo, float hi) { return f2bf(lo) | (f2bf(hi) << 16); }
__device__ __forceinline__ float wave_sum(float v) {
#pragma unroll
    for (int o = 1; o < 64; o <<= 1) v += __shfl_xor(v, o);
    return v;
}
__device__ __forceinline__ void transpose_item(const float* W, int K, int N, bf16* WT, LAS float* scr, int item, int lane) {
    const int nblk = N / 32, kb = item / nblk, nb = item % nblk, k0 = 64 * kb, n0 = 32 * nb;
#pragma unroll 16
    for (int i = 0; i < 32; ++i) { const int kk = 2 * i + (lane >> 5); scr[kk * 33 + (lane & 31)] = W[(size_t)(k0 + kk) * N + n0 + (lane & 31)]; }
    asm volatile("s_waitcnt lgkmcnt(0)" ::: "memory");
    const int c = lane & 7;
#pragma unroll
    for (int j = 0; j < 4; ++j) { const int n = (lane >> 3) + 8 * j; const LAS float* s = scr + (8 * c) * 33 + n;
        v4u o; o.x = pk2(s[0 * 33], s[1 * 33]); o.y = pk2(s[2 * 33], s[3 * 33]); o.z = pk2(s[4 * 33], s[5 * 33]); o.w = pk2(s[6 * 33], s[7 * 33]);
        *(v4u*)(WT + (size_t)(n0 + n) * K + k0 + 8 * c) = o; }
    asm volatile("s_waitcnt lgkmcnt(0)" ::: "memory");
}
__device__ __forceinline__ float xg_row_bf16(const float* xrow, const float* g, bf16* orow, int lane) {
    const f32x4* xr = (const f32x4*)xrow + lane; const f32x4* gr = (const f32x4*)g + lane;
    f32x4 v[8]; float s = 0.f;
#pragma unroll
    for (int j = 0; j < 8; ++j) { v[j] = xr[64 * j]; s += (v[j].x * v[j].x + v[j].y * v[j].y) + (v[j].z * v[j].z + v[j].w * v[j].w); }
    unsigned long long* o8 = (unsigned long long*)orow + lane;
#pragma unroll
    for (int j = 0; j < 8; ++j) { const f32x4 gg = gr[64 * j]; o8[64 * j] = (unsigned long long)pk2(v[j].x * gg.x, v[j].y * gg.y) | ((unsigned long long)pk2(v[j].z * gg.z, v[j].w * gg.w) << 32); }
    return wave_sum(s);
}
struct Args { const float* in[16]; float* out; unsigned char* ws; int ph_lo, ph_hi; };
constexpr int N_PHASES = 2 + 5 * DEPTH;
constexpr size_t WS_SSQ = 0;

__global__ void __launch_bounds__(NWAVES * 64, 2) mega_fwd(Args args) {
    extern __shared__ __attribute__((aligned(16))) unsigned char lds[];
    cg::grid_group grid = cg::this_grid();
    const int tid = threadIdx.x, wave = __builtin_amdgcn_readfirstlane(tid >> 6); int lane = tid & 63;
#define LAUNDER() asm volatile("" : "+v"(lane))
    const int G = gridDim.x, bx = blockIdx.x;
    const int vcu = (G % 8 == 0) ? (bx % 8) * (G / 8) + bx / 8 : bx;
    const int gw = vcu * NWAVES + wave, NGW = G * NWAVES;
    unsigned char* ws = args.ws;
    const float* x_prompt = args.in[0]; const float* x_sample = args.in[1]; const float* rel_bias = args.in[2];
    const float* norm1_g = args.in[3]; const float* w_in = args.in[4];
    const float* lq1 = args.in[5]; const float* lk1 = args.in[6]; const float* lq2 = args.in[7]; const float* lk2 = args.in[8];
    const float* subln_g = args.in[9]; const float* sink = args.in[10]; const float* w_out = args.in[11]; const float* norm2_g = args.in[12];
    const float* w_f1 = args.in[13]; const float* w_f2 = args.in[14]; const float* fin_g = args.in[15];
    float* out = args.out;
    bf16* Win_t = (bf16*)(ws + WS_WIN); bf16* Wout_t = (bf16*)(ws + WS_WOUT); bf16* Wf1_t = (bf16*)(ws + WS_WF1); bf16* Wf2_t = (bf16*)(ws + WS_WF2);
    float* SSQ = (float*)(ws + WS_SSQ);
    bf16* XN = (bf16*)(ws + WS_XN); bf16* HB = (bf16*)(ws + WS_H); bf16* PROJ = (bf16*)(ws + WS_PROJ); bf16* ATT = (bf16*)(ws + WS_ATT);
    const int lo = args.ph_lo, hi = args.ph_hi;
#define IN(k) (lo <= (k) && (k) < hi)
#define SEAM(k) do { if (IN(k) && IN((k) + 1)) grid.sync(); } while (0)

    if (IN(0)) {
        LAUNDER();
        LAS float* scr = (LAS float*)((LAS unsigned char*)lds + wave * 16384);
        constexpr int I_IN = (DM / 64) * (INW / 32), I_OUT = (DM / 64) * (DM / 32), I_F1 = (DM / 64) * (DFF / 32), I_F2 = (DFF / 64) * (DM / 32);
        constexpr int I_L = I_IN + I_OUT + I_F1 + I_F2;
        for (int it = gw; it < DEPTH * I_L; it += NGW) {
            const int l = it / I_L; int r = it % I_L;
            if (r < I_IN) { transpose_item(w_in + (size_t)l * DM * INW, DM, INW, Win_t + (size_t)l * INW * DM, scr, r, lane); continue; } r -= I_IN;
            if (r < I_OUT) { transpose_item(w_out + (size_t)l * DM * DM, DM, DM, Wout_t + (size_t)l * DM * DM, scr, r, lane); continue; } r -= I_OUT;
            if (r < I_F1) { transpose_item(w_f1 + (size_t)l * DM * DFF, DM, DFF, Wf1_t + (size_t)l * DFF * DM, scr, r, lane); continue; } r -= I_F1;
            transpose_item(w_f2 + (size_t)l * DFF * DM, DFF, DM, Wf2_t + (size_t)l * DM * DFF, scr, r, lane);
        }
        for (int i = (vcu * NWAVES * 64 + tid); i < 4 * M; i += G * NWAVES * 64) SSQ[M + i] = 0.f;
        for (int m = gw; m < M; m += NGW) { const float* xr = m < M_P ? x_prompt + (size_t)m * DM : x_sample + (size_t)(m - M_P) * DM; const float sq = xg_row_bf16(xr, norm1_g, XN + (size_t)m * DM, lane); if (lane == 0) SSQ[m] = sq; }
    }
    SEAM(0);
#pragma unroll
    for (int l = 0; l < DEPTH; ++l) {
        const int pb = 1 + 5 * l;
        if (IN(pb)) {
            pg8::Gemm g{XN, Win_t + (size_t)l * INW * DM, M, INW, DM}; pg8::StaticOrder S; S.init(M, INW, G, bx);
            pg8::EpiBf16<0> E{PROJ, INW, SSQ + (size_t)(2 * l) * M};
            pg8::gemm_phase<pg8::EpiBf16<0>, pg8::StaticOrder, true, true>((LAS unsigned char*)lds, g, S, E);
        }
        SEAM(pb);
        if (IN(pb + 1)) {
            LAUNDER();
            const float lambda_init = 0.8f - 0.6f * expf(-0.3f * (float)l);
            float d1 = lq1[l * 64 + lane] * lk1[l * 64 + lane], d2 = lq2[l * 64 + lane] * lk2[l * 64 + lane];
            d1 = wave_sum(d1); d2 = wave_sum(d2);
            const float lam = expf(d1) - expf(d2) + lambda_init;
#pragma unroll 1
            for (int U = vcu; U < 2560; U += G) {
                int pair, qb, S; size_t row0;
                if (U < 2048) { const int r = U >> 8, v = U & 255, x = v >> 5, cu = v & 31; pair = x * 4 + (r >> 1); qb = (r & 1) * 32 + cu; S = SEQ_P; row0 = (size_t)(pair >> 3) * SEQ_P; }
                else { const int U2 = U - 2048; const int r = U2 >> 8, v = U2 & 255, x = v >> 5, cu = v & 31; pair = x * 2 + r; qb = cu; S = SEQ_S; row0 = (size_t)M_P + (size_t)(pair >> 3) * SEQ_S; }
                const int h = pair & 7;
                if (false) att::attn_unit<0, 0>(PROJ + (row0 + qb * 128) * INW + h * 128, PROJ + row0 * INW + 1024 + h * 128, PROJ + row0 * INW + 2048 + h * 128,
                                  ATT + (row0 + qb * 128) * DM + h * 128, qb * 128, 0, S / 64, rel_bias + h, 0.f, lam, 1.f - lambda_init, subln_g + l * 128, (char*)lds);
                else att::attn_unit<0, 1>(PROJ + (row0 + qb * 128) * INW + h * 128, PROJ + row0 * INW + 1024 + h * 128, PROJ + row0 * INW + 2048 + h * 128,
                                  ATT + (row0 + qb * 128) * DM + h * 128, qb * 128, 0, S / 64, rel_bias + h, 0.f, lam, 1.f - lambda_init, subln_g + l * 128, (char*)lds);
            }
#pragma unroll 1
            for (int U3 = vcu; U3 < 1280; U3 += G) {
                const int r = U3 >> 8, v = U3 & 255; const int w = v * 5 + r; const int rbk = w >> 3, hq = w & 7, kvh = hq >> 2;
                const size_t grow = (size_t)rbk * 256;
                const bool isP = grow < (size_t)M_P; const int S = isP ? SEQ_P : SEQ_S;
                const size_t row0 = isP ? (grow / SEQ_P) * SEQ_P : (size_t)M_P + ((grow - M_P) / SEQ_S) * SEQ_S;
                const int q0 = (int)(grow - row0);
                const int kb = q0 - 128 < 0 ? 0 : q0 - 128, ke = q0 + 384 > S ? S : q0 + 384;
                if (false) att::attn_unit<1, 0>(PROJ + grow * INW + 3072 + hq * 128, PROJ + row0 * INW + 4096 + kvh * 128, PROJ + row0 * INW + 4352 + kvh * 128,
                                  ATT + grow * DM + 1024 + hq * 128, q0, kb, (ke - kb) / 64, rel_bias + 8 + hq, sink[l * 8 + hq], 0.f, 1.f, nullptr, (char*)lds);
                else att::attn_unit<1, 1>(PROJ + grow * INW + 3072 + hq * 128, PROJ + row0 * INW + 4096 + kvh * 128, PROJ + row0 * INW + 4352 + kvh * 128,
                                  ATT + grow * DM + 1024 + hq * 128, q0, kb, (ke - kb) / 64, rel_bias + 8 + hq, sink[l * 8 + hq], 0.f, 1.f, nullptr, (char*)lds);
            }
            __syncthreads();
        }
        SEAM(pb + 1);
        if (IN(pb + 2)) {
            pg8::Gemm g{ATT, Wout_t + (size_t)l * DM * DM, M, DM, DM}; pg8::StaticOrder S; S.init(M, DM, G, bx);
            pg8::EpiResF32 E{l == 0 ? x_prompt : out, l == 0 ? x_sample : out + (size_t)M_P * DM, M_P, out, XN, norm2_g + l * DM, SSQ + (size_t)(2 * l + 1) * M};
            pg8::gemm_phase<pg8::EpiResF32, pg8::StaticOrder, true, true>((LAS unsigned char*)lds, g, S, E);
        }
        SEAM(pb + 2);
        if (IN(pb + 3)) {
            pg8::Gemm g{XN, Wf1_t + (size_t)l * DFF * DM, M, DFF, DM}; pg8::StaticOrder S; S.init(M, DFF, G, bx);
            pg8::EpiBf16<1> E{HB, DFF, SSQ + (size_t)(2 * l + 1) * M};
            pg8::gemm_phase<pg8::EpiBf16<1>, pg8::StaticOrder, true, true>((LAS unsigned char*)lds, g, S, E);
        }
        SEAM(pb + 3);
        if (IN(pb + 4)) {
            pg8::Gemm g{HB, Wf2_t + (size_t)l * DM * DFF, M, DM, DFF}; pg8::StaticOrder S; S.init(M, DM, G, bx);
            pg8::EpiResF32 E{out, out + (size_t)M_P * DM, M_P, out, l + 1 < DEPTH ? XN : nullptr, l + 1 < DEPTH ? norm1_g + (l + 1) * DM : fin_g, SSQ + (size_t)(2 * l + 2) * M};
            pg8::gemm_phase<pg8::EpiResF32, pg8::StaticOrder, true, true>((LAS unsigned char*)lds, g, S, E);
        }
        SEAM(pb + 4);
    }
    if (IN(1 + 5 * DEPTH)) {
        LAUNDER();
        const float* sq = SSQ + (size_t)(2 * DEPTH) * M;
        for (int m = gw; m < M; m += NGW) { f32x4* xr = (f32x4*)(out + (size_t)m * DM) + lane; const f32x4* gr = (const f32x4*)fin_g + lane; const float rs = 1.f / sqrtf(sq[m] * (1.f / DM) + 1e-6f);
#pragma unroll
            for (int j = 0; j < 8; ++j) xr[64 * j] = xr[64 * j] * rs * gr[64 * j]; }
    }
#undef IN
#undef SEAM
}

extern "C" void kernel_launch(void* const* d_in, const int* in_sizes, int n_in, void* d_out, int out_size, void* d_ws, size_t ws_size, hipStream_t stream) {
    static int grid = 0;
    if (grid == 0) {
        if (n_in != 16 || in_sizes[0] != M_P * DM || in_sizes[1] != M_S * DM || out_size != M * DM || ws_size < WS_END) {
            fprintf(stderr, "kernel_launch: shape/workspace mismatch: n_in %d in0 %d in1 %d out %d ws %zu (need %zu)\n", n_in, n_in > 0 ? in_sizes[0] : -1, n_in > 1 ? in_sizes[1] : -1, out_size, ws_size, (size_t)WS_END);
            grid = -1; return; }
        int dev = 0, cus = 0, per_cu = 0;
        hipGetDevice(&dev); hipDeviceGetAttribute(&cus, hipDeviceAttributeMultiprocessorCount, dev);
        if (hipFuncSetAttribute((const void*)mega_fwd, hipFuncAttributeMaxDynamicSharedMemorySize, LDS_BYTES) != hipSuccess) { fprintf(stderr, "kernel_launch: hipFuncSetAttribute failed\n"); grid = -1; return; }
        if (hipOccupancyMaxActiveBlocksPerMultiprocessor(&per_cu, (const void*)mega_fwd, NWAVES * 64, LDS_BYTES) != hipSuccess || per_cu < 1) { fprintf(stderr, "kernel_launch: occupancy query gave %d\n", per_cu); per_cu = 1; }
        (void)hipGetLastError();
        grid = cus * per_cu;
    }
    if (grid < 0) return;
    Args a{};
    for (int i = 0; i < 16; ++i) a.in[i] = (const float*)d_in[i];
    a.out = (float*)d_out; a.ws = (unsigned char*)d_ws;
#if MK_MULTI
    for (int p = 0; p < N_PHASES; ++p) { a.ph_lo = p; a.ph_hi = p + 1; void* kargs[] = {&a};
        hipError_t e = hipLaunchCooperativeKernel((const void*)mega_fwd, dim3(grid), dim3(NWAVES * 64), kargs, LDS_BYTES, stream);
        if (e != hipSuccess) { fprintf(stderr, "kernel_launch: launch %d failed: %s (grid %d)\n", p, hipGetErrorString(e), grid); break; } }
#else
    a.ph_lo = 0; a.ph_hi = N_PHASES; void* kargs[] = {&a};
    hipError_t e = hipLaunchCooperativeKernel((const void*)mega_fwd, dim3(grid), dim3(NWAVES * 64), kargs, LDS_BYTES, stream);
    if (e != hipSuccess) fprintf(stderr, "kernel_launch: cooperative launch failed: %s (grid %d)\n", hipGetErrorString(e), grid);
#endif
}
```

```cpp
#include <hip/hip_runtime.h>
#include <hip/hip_bf16.h>
#include <hip/hip_cooperative_groups.h>
#include <cstdio>
#include <cstdint>
namespace cg = cooperative_groups;

#ifndef MK_MULTI
#define MK_MULTI 0
#endif


namespace pg8 {
#define PG8_LAS __attribute__((address_space(3)))
typedef unsigned short bf16_t;
typedef short bf16x8 __attribute__((ext_vector_type(8)));
typedef float f32x4 __attribute__((ext_vector_type(4)));
typedef unsigned u32x4 __attribute__((ext_vector_type(4)));
constexpr int BM = 256, BK = 64, HALF = 128, HTB = HALF * BK * 2  , STAGE_BYTES = 8 * HTB, NXCD = 8, WGM = 8;

__host__ __device__ __forceinline__ int lds_byte(int r, int c) { const int st = (r >> 4) * 2 + (c >> 5), rr = r & 15, cc = c & 31, ob = rr * 64 + cc * 2; return st * 1024 + (ob ^ (((ob >> 9) & 1) << 5)); }
__host__ __device__ __forceinline__ void stage_rc(int b, int& R, int& C) { const int st = b / 1024, sb = b % 1024, swz = sb ^ (((sb >> 9) & 1) << 5); R = (st >> 1) * 16 + swz / 64; C = (st & 1) * 32 + (swz % 64) / 2; }
__host__ __device__ __forceinline__ int perm32(int rho) { const int n = rho >> 4, i = rho & 15; return 8 * (i >> 2) + 4 * n + (i & 3); }

struct Unit { int pm, pn; };
struct Gemm { const bf16_t* A; const bf16_t* Bt; int M, N, K; };

struct StaticOrder {
    int nM, nN, nwg, G, c;
    __host__ __device__ void init(int M, int N, int G_, int c_) { nM = M / BM; nN = N / BM; nwg = nM * nN; G = G_; c = c_; }
    __host__ __device__ bool next(int i, Unit& u) const {
        const long L = (long)i * G + c; if (L >= nwg) return false;
        int wgid = (int)L; { const int q = nwg / NXCD, r = nwg % NXCD, xcd = wgid % NXCD, off = wgid / NXCD; wgid = (xcd < r ? xcd * (q + 1) : r * (q + 1) + (xcd - r) * q) + off; }
        const int nig = WGM * nN, gid = wgid / nig, fm = gid * WGM, gsz = (nM - fm) < WGM ? (nM - fm) : WGM;
        u.pm = fm + ((wgid % nig) % gsz); u.pn = (wgid % nig) / gsz; return true;
    }
    __device__ __forceinline__ void a_ready(const Unit&) const {}
    __device__ __forceinline__ void done(const Unit&) const {}
};

typedef unsigned u32x4 __attribute__((ext_vector_type(4)));
__device__ __forceinline__ unsigned cvt_pk_bf16(float lo, float hi) { unsigned r; asm volatile("v_cvt_pk_bf16_f32 %0, %1, %2" : "=v"(r) : "v"(lo), "v"(hi)); return r; }

template <int ACT  > struct EpiBf16 {
    static constexpr bool PERM = true, AFTER_DRAIN = false;
    bf16_t* O; int ldc; const float* ssq;
    __device__ __forceinline__ void operator()(const f32x4 (&acc)[2][2][4][2], const Unit& u, int wr, int wc, int fr, int fq) const {
        asm volatile("" : "+v"(fr), "+v"(fq));
        const int row0 = u.pm * BM + wr * 64 + fr; const int col0 = u.pn * BM + wc * 32 + 8 * fq;
#pragma unroll
        for (int ai = 0; ai < 2; ++ai)
#pragma unroll
            for (int m = 0; m < 4; ++m) { const int row = row0 + ai * HALF + m * 16; bf16_t* rowp = O + (size_t)row * ldc + col0;
                const float rs = __builtin_amdgcn_rsqf(ssq[row] * (1.f / 2048.f) + 1e-6f);
#pragma unroll
                for (int bj = 0; bj < 2; ++bj) { f32x4 v0 = acc[ai][bj][m][0] * rs, v1 = acc[ai][bj][m][1] * rs;
                    if (ACT == 1) {
#pragma unroll
                        for (int e = 0; e < 4; ++e) { float a = fmaxf(v0[e], 0.f), b = fmaxf(v1[e], 0.f); v0[e] = a * a; v1[e] = b * b; } }
                    u32x4 w; w.x = cvt_pk_bf16(v0[0], v0[1]); w.y = cvt_pk_bf16(v0[2], v0[3]); w.z = cvt_pk_bf16(v1[0], v1[1]); w.w = cvt_pk_bf16(v1[2], v1[3]);
                    __builtin_nontemporal_store(w, (u32x4*)(rowp + bj * HALF)); } }
    }
};
struct EpiResF32 {
    static constexpr bool PERM = true, AFTER_DRAIN = false;
    const float* b0; const float* b1; int split; float* out; bf16_t* xn; const float* g; float* ssq;
    __device__ __forceinline__ void operator()(const f32x4 (&acc)[2][2][4][2], const Unit& u, int wr, int wc, int fr, int fq) const {
        asm volatile("" : "+v"(fr), "+v"(fq));
        const int col0 = u.pn * BM + wc * 32 + 8 * fq;
        const int rt = u.pm * BM; const float* bb = (rt < split) ? b0 + (size_t)rt * 2048 : b1 + (size_t)(rt - split) * 2048; float* oo = out + (size_t)rt * 2048; bf16_t* xx = xn + (size_t)rt * 2048;
        float sacc[2][4];
        f32x4 gv[2][2];
#pragma unroll
        for (int bj = 0; bj < 2; ++bj) { gv[bj][0] = *(const f32x4*)(g + col0 + bj * HALF); gv[bj][1] = *(const f32x4*)(g + col0 + bj * HALF + 4); }
#pragma unroll
        for (int ai = 0; ai < 2; ++ai) {
            f32x4 pre[4][2][2];
#pragma unroll
            for (int m = 0; m < 4; ++m) { const size_t off = (size_t)(ai * HALF + wr * 64 + m * 16 + fr) * 2048 + col0;
#pragma unroll
                for (int bj = 0; bj < 2; ++bj) { pre[m][bj][0] = *(const f32x4*)(bb + off + bj * HALF); pre[m][bj][1] = *(const f32x4*)(bb + off + bj * HALF + 4); } }
            asm volatile("" ::: "memory");
#pragma unroll
            for (int m = 0; m < 4; ++m) { const int rl = ai * HALF + wr * 64 + m * 16 + fr; const size_t off = (size_t)rl * 2048 + col0; float s = 0.f;
#pragma unroll
                for (int bj = 0; bj < 2; ++bj) {
                    const f32x4 v0 = pre[m][bj][0] + acc[ai][bj][m][0], v1 = pre[m][bj][1] + acc[ai][bj][m][1];
                    *(f32x4*)(oo + off + bj * HALF) = v0; *(f32x4*)(oo + off + bj * HALF + 4) = v1;
                    s += (v0[0] * v0[0] + v0[1] * v0[1]) + (v0[2] * v0[2] + v0[3] * v0[3]) + (v1[0] * v1[0] + v1[1] * v1[1]) + (v1[2] * v1[2] + v1[3] * v1[3]);
                    const f32x4 a = v0 * gv[bj][0], b = v1 * gv[bj][1];
                    u32x4 w; w.x = cvt_pk_bf16(a[0], a[1]); w.y = cvt_pk_bf16(a[2], a[3]); w.z = cvt_pk_bf16(b[0], b[1]); w.w = cvt_pk_bf16(b[2], b[3]);
                    if (xn) *(u32x4*)(xx + off + bj * HALF) = w; }
                s += __shfl_xor(s, 16); s += __shfl_xor(s, 32); sacc[ai][m] = s; }
            asm volatile("" ::: "memory");
        }
        if (fq == 0) {
#pragma unroll
            for (int ai = 0; ai < 2; ++ai)
#pragma unroll
                for (int m = 0; m < 4; ++m) atomicAdd(ssq + rt + ai * HALF + wr * 64 + m * 16 + fr, sacc[ai][m]); }
    }
};
template <class Epi, class Sched, bool ALIGN_EPI = false, bool SP2 = false>
__device__ __forceinline__ void gemm_phase(PG8_LAS unsigned char* lds, const Gemm g, const Sched& S, const Epi& E) {
    int tid_ = threadIdx.x; asm volatile("" : "+v"(tid_));
    const int tid = tid_, wid = __builtin_amdgcn_readfirstlane(tid >> 6), lane = tid & 63, wr = wid >> 2, wc = wid & 3, fr = lane & 15, fq = lane >> 4;
    const int K = g.K, nt = K / BK;
    unsigned voffA[2], voffB[2];
#pragma unroll
    for (int i = 0; i < 2; ++i) { int R, C; stage_rc(tid * 16 + i * 8192, R, C); const int Rb = Epi::PERM ? ((R & ~31) + perm32(R & 31)) : R;
        voffA[i] = (unsigned)(R * K + C) * 2u; voffB[i] = (unsigned)(Rb * K + C) * 2u; }
    const size_t kstep = (size_t)(BK * 2);
    const size_t hstep = (size_t)HALF * K * 2;
    const size_t tstep = 2 * hstep;
    const unsigned ldsw = (unsigned)wid * 1024u;
    const int aoff = lds_byte(wr * 64 + fr, fq * 8), boff = lds_byte(wc * 32 + fr, fq * 8);
#define PG8_SA(b, h) (((b) * 2 + (h)) * HTB)
#define PG8_SB(b, h) ((4 + (b) * 2 + (h)) * HTB)
#define PG8_STAGE(bufoff, gbase, voff) do { _Pragma("unroll") for (int _i = 0; _i < 2; ++_i) \
        __builtin_amdgcn_global_load_lds((const unsigned*)((const char*)(gbase) + (voff)[_i]), (PG8_LAS unsigned*)(lds + (bufoff) + ldsw + _i * 8192), 16, 0, 0); } while (0)
#define PG8_LDA(dst, b, h) do { _Pragma("unroll") for (int m = 0; m < 4; ++m) _Pragma("unroll") for (int k = 0; k < 2; ++k) dst[m][k] = *(const PG8_LAS bf16x8*)(lds + PG8_SA(b, h) + aoff + m * 2048 + k * 1024); } while (0)
#define PG8_LDB(dst, b, h) do { _Pragma("unroll") for (int n = 0; n < 2; ++n) _Pragma("unroll") for (int k = 0; k < 2; ++k) dst[n][k] = *(const PG8_LAS bf16x8*)(lds + PG8_SB(b, h) + boff + n * 2048 + k * 1024); } while (0)
#define PG8_MMA(ai, bj, At, Bt) do { __builtin_amdgcn_s_setprio(1); _Pragma("unroll") for (int m = 0; m < 4; ++m) _Pragma("unroll") for (int n = 0; n < 2; ++n) _Pragma("unroll") for (int k = 0; k < 2; ++k) \
        acc[ai][bj][m][n] = __builtin_amdgcn_mfma_f32_16x16x32_bf16(Bt[n][k], At[m][k], acc[ai][bj][m][n], 0, 0, 0); __builtin_amdgcn_s_setprio(0); } while (0)
#define PG8_WAIT_V(n) asm volatile("s_waitcnt vmcnt(" #n ")" ::: "memory")
#define PG8_WAIT_L(n) asm volatile("s_waitcnt lgkmcnt(" #n ")" ::: "memory")
#define PG8_BAR __builtin_amdgcn_s_barrier()
#define PG8_SCHED __builtin_amdgcn_sched_barrier(0)
    Unit cur, nxt; int ui = 0;
    if (!S.next(0, cur)) return;
    f32x4 acc[2][2][4][2];
#pragma unroll
    for (int a = 0; a < 2; ++a)
#pragma unroll
        for (int b = 0; b < 2; ++b)
#pragma unroll
            for (int m = 0; m < 4; ++m)
#pragma unroll
                for (int n = 0; n < 2; ++n) acc[a][b][m][n] = (f32x4){0.f, 0.f, 0.f, 0.f};
    bf16x8 At[4][2], B0[2][2], B1[2][2];
    const char* cA = (const char*)g.A + (size_t)cur.pm * tstep; const char* cB = (const char*)g.Bt + (size_t)cur.pn * tstep;
    S.a_ready(cur);
    if constexpr (SP2) {
        PG8_STAGE(PG8_SB(0, 0), cB, voffB); PG8_STAGE(PG8_SB(0, 1), cB + hstep, voffB); PG8_STAGE(PG8_SA(0, 0), cA, voffA); PG8_STAGE(PG8_SA(0, 1), cA + hstep, voffA);
        if (wr == 1) PG8_BAR;
        PG8_WAIT_V(2); PG8_BAR;
        PG8_STAGE(PG8_SB(1, 0), cB + kstep, voffB); PG8_STAGE(PG8_SA(1, 0), cA + kstep, voffA); PG8_STAGE(PG8_SB(1, 1), cB + hstep + kstep, voffB);
        PG8_WAIT_V(6); PG8_BAR;
    } else {
        PG8_STAGE(PG8_SB(0, 0), cB, voffB); PG8_STAGE(PG8_SA(0, 0), cA, voffA); PG8_STAGE(PG8_SB(0, 1), cB + hstep, voffB); PG8_STAGE(PG8_SA(0, 1), cA + hstep, voffA);
        if (wr == 1) PG8_BAR;
        PG8_WAIT_V(4); PG8_BAR;
        PG8_STAGE(PG8_SB(1, 0), cB + kstep, voffB); PG8_STAGE(PG8_SA(1, 0), cA + kstep, voffA); PG8_STAGE(PG8_SB(1, 1), cB + hstep + kstep, voffB);
        PG8_WAIT_V(6); PG8_BAR;
    }
    for (;;) {
        const bool has_next = S.next(ui + 1, nxt);
        const char* nA = has_next ? (const char*)g.A + (size_t)nxt.pm * tstep : cA; const char* nB = has_next ? (const char*)g.Bt + (size_t)nxt.pn * tstep : cB;
        for (int t = 0; t < nt; t += 2) {
            const bool last = (t == nt - 2);
            const char* a1 = cA + (size_t)(t + 1) * kstep;
            const char* a2 = last ? nA : cA + (size_t)(t + 2) * kstep; const char* b2 = last ? nB : cB + (size_t)(t + 2) * kstep;
            const char* a3 = a2 + kstep; const char* b3 = b2 + kstep;
            if (last && has_next) S.a_ready(nxt);
            if constexpr (SP2) {
            PG8_LDB(B0, 0, 0); PG8_LDB(B1, 0, 1); PG8_SCHED; PG8_LDA(At, 0, 0); PG8_STAGE(PG8_SA(1, 1), a1 + hstep, voffA);
            PG8_WAIT_V(8); PG8_WAIT_L(0); PG8_BAR; PG8_MMA(0, 0, At, B0); PG8_MMA(0, 1, At, B1); PG8_BAR; PG8_SCHED;
            PG8_LDA(At, 0, 1); PG8_STAGE(PG8_SB(0, 0), b2, voffB); PG8_STAGE(PG8_SB(0, 1), b2 + hstep, voffB); PG8_STAGE(PG8_SA(0, 0), a2, voffA);
            PG8_WAIT_V(8); PG8_WAIT_L(0); PG8_BAR; PG8_MMA(1, 0, At, B0); PG8_MMA(1, 1, At, B1); PG8_BAR; PG8_SCHED;
            PG8_LDB(B0, 1, 0); PG8_LDB(B1, 1, 1); PG8_SCHED; PG8_LDA(At, 1, 0); PG8_STAGE(PG8_SA(0, 1), a2 + hstep, voffA);
            PG8_WAIT_V(8); PG8_WAIT_L(0); PG8_BAR; PG8_MMA(0, 0, At, B0); PG8_MMA(0, 1, At, B1); PG8_BAR; PG8_SCHED;
            PG8_LDA(At, 1, 1); PG8_STAGE(PG8_SB(1, 0), b3, voffB); PG8_STAGE(PG8_SB(1, 1), b3 + hstep, voffB); PG8_STAGE(PG8_SA(1, 0), a3, voffA);
            PG8_WAIT_V(8); PG8_WAIT_L(0); PG8_BAR; PG8_MMA(1, 0, At, B0); PG8_MMA(1, 1, At, B1); PG8_BAR; PG8_SCHED;
            } else {
            PG8_LDB(B0, 0, 0); PG8_SCHED; PG8_LDA(At, 0, 0); PG8_STAGE(PG8_SA(1, 1), a1 + hstep, voffA);
            PG8_WAIT_L(8); PG8_BAR; PG8_WAIT_L(0); PG8_MMA(0, 0, At, B0); PG8_BAR; PG8_SCHED;
            PG8_LDB(B1, 0, 1); PG8_STAGE(PG8_SB(0, 0), b2, voffB);
            PG8_BAR; PG8_WAIT_L(0); PG8_MMA(0, 1, At, B1); PG8_BAR;
            PG8_LDA(At, 0, 1); PG8_STAGE(PG8_SA(0, 0), a2, voffA);
            PG8_BAR; PG8_WAIT_L(0); PG8_MMA(1, 0, At, B0); PG8_BAR; PG8_SCHED;
            PG8_STAGE(PG8_SB(0, 1), b2 + hstep, voffB);
            PG8_WAIT_V(6); PG8_BAR; PG8_MMA(1, 1, At, B1); PG8_BAR;
            PG8_LDB(B0, 1, 0); PG8_SCHED; PG8_LDA(At, 1, 0); PG8_STAGE(PG8_SA(0, 1), a2 + hstep, voffA);
            PG8_WAIT_L(8); PG8_BAR; PG8_WAIT_L(0); PG8_MMA(0, 0, At, B0); PG8_BAR; PG8_SCHED;
            PG8_LDB(B1, 1, 1); PG8_STAGE(PG8_SB(1, 0), b3, voffB);
            PG8_BAR; PG8_WAIT_L(0); PG8_MMA(0, 1, At, B1); PG8_BAR;
            PG8_LDA(At, 1, 1); PG8_STAGE(PG8_SA(1, 0), a3, voffA);
            PG8_BAR; PG8_WAIT_L(0); PG8_MMA(1, 0, At, B0); PG8_BAR; PG8_SCHED;
            PG8_STAGE(PG8_SB(1, 1), b3 + hstep, voffB);
            PG8_WAIT_V(6); PG8_BAR; PG8_MMA(1, 1, At, B1); PG8_BAR;
            }
        }
        if constexpr (ALIGN_EPI) { if (wr == 0) PG8_BAR; }
        if constexpr (!Epi::AFTER_DRAIN) { E(acc, cur, wr, wc, fr, fq); S.done(cur); }
        if (!has_next) break;
#pragma unroll
        for (int a = 0; a < 2; ++a)
#pragma unroll
            for (int b = 0; b < 2; ++b)
#pragma unroll
                for (int m = 0; m < 4; ++m)
#pragma unroll
                    for (int n = 0; n < 2; ++n) acc[a][b][m][n] = (f32x4){0.f, 0.f, 0.f, 0.f};
        cur = nxt; cA = nA; cB = nB; ++ui;
        if constexpr (ALIGN_EPI) { if (wr == 1) PG8_BAR; }
    }
    PG8_WAIT_V(0);
    if constexpr (!ALIGN_EPI) { if (wr == 0) PG8_BAR; }
    PG8_BAR;
    if constexpr (Epi::AFTER_DRAIN) { E.fused(acc, cur, wr, wc, fr, fq, lds, wid, lane); S.done(cur); }
#undef PG8_SA
#undef PG8_SB
#undef PG8_STAGE
#undef PG8_LDA
#undef PG8_LDB
#undef PG8_MMA
#undef PG8_WAIT_V
#undef PG8_WAIT_L
#undef PG8_BAR
#undef PG8_SCHED
}
}
namespace att {
using bf16 = unsigned short;
using bf16x8 = __attribute__((ext_vector_type(8))) short;
using s16x4  = __attribute__((ext_vector_type(4))) short;
using f32x16 = __attribute__((ext_vector_type(16))) float;
using u32x4  = __attribute__((ext_vector_type(4))) unsigned;
constexpr int KVBLK = 64, LDP = 4608, LDO = 2048;
constexpr int SHM_V = 16384, SHM_K = 16384;
constexpr int SLOT = SHM_V + SHM_K, NSLOT = 3;
constexpr int OFF_V = 0, OFF_K = SHM_V, OFF_WS = NSLOT * SLOT, OFF_TAB = OFF_WS + 8 * 64 * 4, ATT_LDS = OFF_TAB + 272 * 4;
constexpr float LOG2E = 1.4426950408889634f;
constexpr float THR = 8.f;
constexpr float NEGB = -1e30f;
#define KSWZ(row, colB) ((row) * 256 + ((colB) ^ (((row) & 7) << 4)))
#define SBAR() __builtin_amdgcn_sched_barrier(0)
__device__ __forceinline__ int crow(int r, int hi) { return (r & 3) + 8 * (r >> 2) + 4 * hi; }
__device__ __forceinline__ unsigned cvtpk(float lo, float hi) { unsigned r; asm volatile("v_cvt_pk_bf16_f32 %0, %1, %2" : "=v"(r) : "v"(lo), "v"(hi)); return r; }
__device__ __forceinline__ bf16x8 ld8(const bf16* p) { return *reinterpret_cast<const bf16x8*>(p); }

__device__ __forceinline__ int t5_bucket(int rel) {
  const int n = rel < 0 ? -rel : rel; int b;
  if (n < 8) b = n; else { int l = (31 - __builtin_clz((unsigned)(n * n))) - 6; b = 8 + l; if (b > 15) b = 15; }
  return (rel > 0 ? 16 : 0) + b;
}

__device__ __forceinline__ float max3f(float a, float b, float c) { float r; asm("v_max3_f32 %0, %1, %2, %3" : "=v"(r) : "v"(a), "v"(b), "v"(c)); return r; }
__device__ __forceinline__ void partialSM(f32x16& p0, f32x16& p1, float& m_reg, float& alpha, float Ce, float be) {
  float pmax = max3f(p0[0], p0[1], p1[0]), pmb = max3f(p0[2], p0[3], p1[1]);
  pmax = max3f(pmax, p1[2], p1[3]);
#pragma unroll
  for (int r = 4; r < 16; r += 4) { pmax = max3f(pmax, p0[r], p0[r + 1]); pmb = max3f(pmb, p0[r + 2], p0[r + 3]); pmax = max3f(pmax, p1[r], p1[r + 1]); pmb = max3f(pmb, p1[r + 2], p1[r + 3]); }
  pmax = max3f(pmax, pmb, pmb);
  { auto rr = __builtin_amdgcn_permlane32_swap(__float_as_uint(pmax), __float_as_uint(pmax), false, false);
    pmax = fmaxf(__uint_as_float(rr[0]), __uint_as_float(rr[1])); }
  pmax = fmaf(pmax, Ce, be);
  float mn;
  if (__builtin_expect(__all(pmax - m_reg <= THR), 1)) { mn = m_reg; alpha = 1.f; }
  else { mn = fmaxf(m_reg, pmax); alpha = __builtin_amdgcn_exp2f(m_reg - mn); m_reg = mn; }
  const float off = be - mn;
#pragma unroll
  for (int r = 0; r < 16; ++r) p0[r] = fmaf(p0[r], Ce, off);
#pragma unroll
  for (int r = 0; r < 16; ++r) p1[r] = fmaf(p1[r], Ce, off);
#pragma unroll
  for (int r = 0; r < 16; ++r) p0[r] = __builtin_amdgcn_exp2f(p0[r]);
}
__device__ __forceinline__ void finishSM(f32x16& p0, f32x16& p1, float alpha, float& l_reg, bf16x8& pa0, bf16x8& pa1, bf16x8& pa2, bf16x8& pa3) {
#pragma unroll
  for (int r = 0; r < 16; ++r) p1[r] = __builtin_amdgcn_exp2f(p1[r]);
  float ps = 0;
#pragma unroll
  for (int r = 0; r < 16; ++r) ps += p0[r];
#pragma unroll
  for (int r = 0; r < 16; ++r) ps += p1[r];
  { auto rr = __builtin_amdgcn_permlane32_swap(__float_as_uint(ps), __float_as_uint(ps), false, false);
    ps = __uint_as_float(rr[0]) + __uint_as_float(rr[1]); }
  l_reg = l_reg * alpha + ps;
#define PK4(P, BASE, OUT) do { unsigned a0 = cvtpk(P[BASE + 0], P[BASE + 1]), a1 = cvtpk(P[BASE + 2], P[BASE + 3]);   \
    unsigned b0 = cvtpk(P[BASE + 4], P[BASE + 5]), b1 = cvtpk(P[BASE + 6], P[BASE + 7]);                              \
    auto r0 = __builtin_amdgcn_permlane32_swap(a0, b0, false, false); auto r1 = __builtin_amdgcn_permlane32_swap(a1, b1, false, false); \
    u32x4 w = {r0[0], r1[0], r0[1], r1[1]}; OUT = *reinterpret_cast<bf16x8*>(&w); } while (0)
  PK4(p0, 0, pa0); PK4(p0, 8, pa1); PK4(p1, 0, pa2); PK4(p1, 8, pa3);
#undef PK4
}
__device__ __forceinline__ bf16x8 scale_bf16x8(bf16x8 v, float c) {
  u32x4 w = *reinterpret_cast<u32x4*>(&v), o;
#pragma unroll
  for (int i = 0; i < 4; ++i) { const float lo = __uint_as_float(w[i] << 16), hh = __uint_as_float(w[i] & 0xffff0000u); o[i] = cvtpk(lo * c, hh * c); }
  return *reinterpret_cast<bf16x8*>(&o);
}
template <int ND0> __device__ __forceinline__ void qkt(f32x16& p0, f32x16& p1, const char* Ks, const bf16x8* qr, int r32, int hi, int cboff, const f32x16& ci) {
#pragma unroll
  for (int d0 = 0; d0 < ND0; ++d0) { int cb = cboff + (d0 * 16 + hi * 8) * 2;
    bf16x8 b0 = *reinterpret_cast<const bf16x8*>(Ks + KSWZ(r32, cb));
    bf16x8 b1 = *reinterpret_cast<const bf16x8*>(Ks + KSWZ(32 + r32, cb));
    if (d0 == 0) { p0 = __builtin_amdgcn_mfma_f32_32x32x16_bf16(b0, qr[0], ci, 0, 0, 0); p1 = __builtin_amdgcn_mfma_f32_32x32x16_bf16(b1, qr[0], ci, 0, 0, 0); }
    else { p0 = __builtin_amdgcn_mfma_f32_32x32x16_bf16(b0, qr[d0], p0, 0, 0, 0); p1 = __builtin_amdgcn_mfma_f32_32x32x16_bf16(b1, qr[d0], p1, 0, 0, 0); } }
}
template <bool FIRST> __device__ __forceinline__ void partialSM2(f32x16& p0, f32x16& p1, float& m_ref, f32x16& negm, float& alpha) {
  float pmax = max3f(p0[0], p0[1], p1[0]), pmb = max3f(p0[2], p0[3], p1[1]);
  pmax = max3f(pmax, p1[2], p1[3]);
#pragma unroll
  for (int r = 4; r < 16; r += 4) { pmax = max3f(pmax, p0[r], p0[r + 1]); pmb = max3f(pmb, p0[r + 2], p0[r + 3]); pmax = max3f(pmax, p1[r], p1[r + 1]); pmb = max3f(pmb, p1[r + 2], p1[r + 3]); }
  pmax = max3f(pmax, pmb, pmb);
  { auto rr = __builtin_amdgcn_permlane32_swap(__float_as_uint(pmax), __float_as_uint(pmax), false, false);
    pmax = fmaxf(__uint_as_float(rr[0]), __uint_as_float(rr[1])); }
  alpha = 1.f;
  if (FIRST || !__builtin_expect(__all(pmax <= THR), 1)) {
    const float dl = FIRST ? pmax : fmaxf(pmax, 0.f); m_ref += dl; if (!FIRST) alpha = __builtin_amdgcn_exp2f(-dl);
#pragma unroll
    for (int r = 0; r < 16; ++r) { p0[r] -= dl; p1[r] -= dl; negm[r] -= dl; }
  }
#pragma unroll
  for (int r = 0; r < 16; ++r) p0[r] = __builtin_amdgcn_exp2f(p0[r]);
}
__device__ __forceinline__ int v_st(int k, int c) { const int kk = (k & ~0xC) | ((k & 4) << 1) | ((k & 8) >> 1); return ((kk >> 3) * 4 + (c >> 5)) * 512 + ((kk & 7) * 32 + (c & 31)) * 2; }
__device__ __forceinline__ int v_rd_base(int lane) { return ((lane & 3) << 3) | (((lane >> 2) & 3) << 6) | (((lane >> 4) & 1) << 5) | (((lane >> 5) & 1) << 8); }
constexpr int v_rd_off(int d0, int ks, int half) { return d0 * 512 + ks * 4096 + half * 2048; }
template <int OFF> __device__ __forceinline__ s16x4 tr_read(int vb) {
  s16x4 r; asm volatile("ds_read_b64_tr_b16 %0, %1 offset:%2" : "=&v"(r) : "v"(vb), "i"(OFF) : "memory"); return r;
}
#define VRD8(D0, L0, H0, L1, H1, L2, H2, L3, H3) do { L0 = tr_read<v_rd_off(D0, 0, 0)>(vb); H0 = tr_read<v_rd_off(D0, 0, 1)>(vb); L1 = tr_read<v_rd_off(D0, 1, 0)>(vb); H1 = tr_read<v_rd_off(D0, 1, 1)>(vb); \
    L2 = tr_read<v_rd_off(D0, 2, 0)>(vb); H2 = tr_read<v_rd_off(D0, 2, 1)>(vb); L3 = tr_read<v_rd_off(D0, 3, 0)>(vb); H3 = tr_read<v_rd_off(D0, 3, 1)>(vb); } while (0)
#define PK(L, H) (bf16x8){L[0], L[1], L[2], L[3], H[0], H[1], H[2], H[3]}
#define MMA4(OD, L0, H0, L1, H1, L2, H2, L3, H3) do { OD = __builtin_amdgcn_mfma_f32_32x32x16_bf16(pa0, PK(L0, H0), OD, 0, 0, 0); OD = __builtin_amdgcn_mfma_f32_32x32x16_bf16(pa1, PK(L1, H1), OD, 0, 0, 0); \
    OD = __builtin_amdgcn_mfma_f32_32x32x16_bf16(pa2, PK(L2, H2), OD, 0, 0, 0); OD = __builtin_amdgcn_mfma_f32_32x32x16_bf16(pa3, PK(L3, H3), OD, 0, 0, 0); } while (0)
__device__ __forceinline__ void pv_d0(f32x16* o, int vb, bf16x8 pa0, bf16x8 pa1, bf16x8 pa2, bf16x8 pa3) {
  s16x4 a0, a1, a2, a3, a4, a5, a6, a7, b0, b1, b2, b3, b4, b5, b6, b7;
  VRD8(0, a0, a1, a2, a3, a4, a5, a6, a7);
  VRD8(1, b0, b1, b2, b3, b4, b5, b6, b7);
  asm volatile("s_waitcnt lgkmcnt(8)" ::: "memory"); SBAR();
  MMA4(o[0], a0, a1, a2, a3, a4, a5, a6, a7); SBAR();
  VRD8(2, a0, a1, a2, a3, a4, a5, a6, a7);
  asm volatile("s_waitcnt lgkmcnt(8)" ::: "memory"); SBAR();
  MMA4(o[1], b0, b1, b2, b3, b4, b5, b6, b7); SBAR();
  VRD8(3, b0, b1, b2, b3, b4, b5, b6, b7);
  asm volatile("s_waitcnt lgkmcnt(8)" ::: "memory"); SBAR();
  MMA4(o[2], a0, a1, a2, a3, a4, a5, a6, a7); SBAR();
  asm volatile("s_waitcnt lgkmcnt(0)" ::: "memory"); SBAR();
  MMA4(o[3], b0, b1, b2, b3, b4, b5, b6, b7);
}
#undef VRD8
#undef PK
#undef MMA4

template <int MODE, int ORD>
__device__ __forceinline__ void attn_unit(const bf16* __restrict__ Qb, const bf16* __restrict__ Kh, const bf16* __restrict__ Vh, bf16* __restrict__ Ob,
                                          int qpos0, int kbeg, int NT, const float* __restrict__ tabsrc, float sinkv, float lam, float oscale,
                                          const float* __restrict__ subg, char* lds) {
  constexpr int ND0 = MODE == 0 ? 4 : 8;
  const float C = (MODE == 0 ? 0.125f : 0.08838834764831845f) * LOG2E;
  int tid_ = threadIdx.x; asm volatile("" : "+v"(tid_));
  const int tid = tid_, wid = __builtin_amdgcn_readfirstlane(tid >> 6), lane = tid & 63; int r32 = lane & 31, hi = lane >> 5;
  const int wq = MODE == 0 ? (wid & 3) : wid, cst = MODE == 0 ? (wid >> 2) : 0;
  char* V_lds = lds + OFF_V; char* K_lds = lds + OFF_K;
  float* wsf = (float*)(lds + OFF_WS) + wid * 64; float* li_l = wsf; float* al_l = wsf + 32;
  float* tab = (float*)(lds + OFF_TAB);
  __syncthreads();
  if (wid >= 4) __builtin_amdgcn_s_setprio(1);
  if (tid < 257) tab[tid] = tabsrc[t5_bucket(tid - 128) * 16] * LOG2E;
  float m_reg = MODE == 0 ? 0.f : sinkv * LOG2E, l_reg = MODE == 0 ? 0.f : 1.f;
  f32x16 o[4] = {}; bf16x8 qr[ND0];
  const bf16* Qw = Qb + (long)(wq * 32 + r32) * LDP + cst * 64 + hi * 8;
#pragma unroll
  for (int d0 = 0; d0 < ND0; ++d0) qr[d0] = scale_bf16x8(ld8(Qw + d0 * 16), C);
  const int qpos = qpos0 + wq * 32 + r32;
  const int qw0 = qpos0 + wq * 32;
  const int cboff = cst * 128;
  int sr = tid >> 4, sc = (tid & 15) * 8, vst0 = v_st(sr, sc), vst1 = v_st(32 + sr, sc);
  int vb0 = (int)(uintptr_t)V_lds + v_rd_base(lane);
  const bf16* Kg = Kh + (long)kbeg * LDP; const bf16* Vg = Vh + (long)kbeg * LDP;
  struct { bf16x8 vs0, vs1, ks0, ks1; } sr_[1];
#define SLOAD(i, k0) do { sr_[i].vs0 = ld8(&Vg[(long)((k0) + sr) * LDP + sc]); sr_[i].vs1 = ld8(&Vg[(long)((k0) + 32 + sr) * LDP + sc]); \
    sr_[i].ks0 = ld8(&Kg[(long)((k0) + sr) * LDP + sc]); sr_[i].ks1 = ld8(&Kg[(long)((k0) + 32 + sr) * LDP + sc]); } while (0)
#define SWRITE(off, i) do { *(bf16x8*)(V_lds + (off) + vst0) = sr_[i].vs0;          \
    *(bf16x8*)(V_lds + (off) + vst1) = sr_[i].vs1; int kc = sc * 2;               \
    *(bf16x8*)(K_lds + (off) + KSWZ(sr, kc)) = sr_[i].ks0;                       \
    *(bf16x8*)(K_lds + (off) + KSWZ(32 + sr, kc)) = sr_[i].ks1; } while (0)
#define SWAIT() asm volatile("s_waitcnt vmcnt(0)" ::: "memory")
#define RESC(a) do { if (__any((a) < 1.f)) { if (hi == 0) al_l[r32] = (a); asm volatile("s_waitcnt lgkmcnt(0)" ::: "memory"); \
    _Pragma("unroll") for (int d = 0; d < 4; ++d) _Pragma("unroll") for (int r = 0; r < 16; ++r) o[d][r] *= al_l[crow(r, hi)]; } } while (0)
  float bL, bR, be_cur = 0.f; f32x16 negm;
#pragma unroll
  for (int r = 0; r < 16; ++r) negm[r] = -m_reg;
#define TCLS(t) const int k0_ = kbeg + (t) * KVBLK; const int rmax_ = k0_ + 63 - qw0, rmin_ = k0_ - qw0 - 31; const bool near_ = (MODE == 1) || (rmax_ > -128 && rmin_ < 128)
#define SETBE(t) do { TCLS(t); const float bt_ = near_ ? 0.f : ((rmax_ <= -128) ? bL : bR); \
    if (bt_ != be_cur) { const float d_ = bt_ - be_cur; _Pragma("unroll") for (int r = 0; r < 16; ++r) negm[r] += d_; be_cur = bt_; } } while (0)
#define BIAS(P0, P1, t) do { TCLS(t); (void)rmin_; (void)rmax_; \
    if (near_) { asm volatile("" ::: "memory");     \
      const int base_ = k0_ - qpos + 128 + 4 * hi; \
      _Pragma("unroll") for (int r = 0; r < 16; ++r) { const int i0 = base_ + (r & 3) + 8 * (r >> 2), i1 = i0 + 32; \
        const int c0 = i0 < 0 ? 0 : (i0 > 256 ? 256 : i0), c1 = i1 < 0 ? 0 : (i1 > 256 ? 256 : i1); \
        const float t0 = P0[r] + tab[c0], t1 = P1[r] + tab[c1]; \
        if (MODE == 1) { P0[r] = (i0 == c0) ? t0 : NEGB; P1[r] = (i1 == c1) ? t1 : NEGB; } else { P0[r] = t0; P1[r] = t1; } } \
      asm volatile("" ::: "memory"); } } while (0)
  f32x16 pA0, pA1, pB0, pB1; float alA, alB; bf16x8 pa0, pa1, pa2, pa3;
  constexpr int SE = 0, SO = 0;
  SLOAD(SE, 0); asm volatile("s_waitcnt vmcnt(0)" ::: "memory"); SWRITE(0, SE); __syncthreads();
  bL = tab[0]; bR = tab[256];
  SETBE(0); qkt<ND0>(pA0, pA1, K_lds, qr, r32, hi, cboff, negm); BIAS(pA0, pA1, 0); partialSM2<MODE == 0>(pA0, pA1, m_reg, negm, alA);
  SLOAD(SO, KVBLK);
  SWAIT(); SWRITE(SLOT, SO); __syncthreads();
  int op = 0, oc = SLOT, on = 2 * SLOT;
#define ROT() do { const int t_ = op; op = oc; oc = on; on = t_; } while (0)
#define TILE_STEP1(PN0, PN1, ALN, PO0, PO1, ALO, TN, LOADS) do { \
      SBAR(); finishSM(PO0, PO1, ALO, l_reg, pa0, pa1, pa2, pa3); SBAR(); LOADS; SETBE(TN); SBAR(); qkt<ND0>(PN0, PN1, K_lds + oc, qr, r32, hi, cboff, negm); SBAR(); \
      BIAS(PN0, PN1, TN); partialSM2<false>(PN0, PN1, m_reg, negm, ALN); SBAR(); pv_d0(o, vb0 + op, pa0, pa1, pa2, pa3); } while (0)
#define MAIN_LOOP(TS) do { \
  for (int j = 1; j + 1 < NT; j += 2) { \
    TS(pB0, pB1, alB, pA0, pA1, alA, j, SLOAD(SO, (j + 1) * KVBLK)); \
    SWAIT(); SWRITE(on, SE); RESC(alB); __syncthreads(); ROT(); \
    TS(pA0, pA1, alA, pB0, pB1, alB, j + 1, SLOAD(SE, (j + 2) * KVBLK)); \
    SWAIT(); SWRITE(on, SO); RESC(alA); __syncthreads(); ROT(); \
  } \
  TS(pB0, pB1, alB, pA0, pA1, alA, NT - 1, (void)0); } while (0)
  MAIN_LOOP(TILE_STEP1);
#undef MAIN_LOOP
#undef TILE_STEP1
#undef SETBE
#undef TCLS
  RESC(alB);
  finishSM(pB0, pB1, alB, l_reg, pa0, pa1, pa2, pa3); SBAR();
  pv_d0(o, vb0 + oc, pa0, pa1, pa2, pa3);
#undef ROT
  if (hi == 0) li_l[r32] = l_reg; asm volatile("s_waitcnt lgkmcnt(0)" ::: "memory");
  float rli[16];
#pragma unroll
  for (int r = 0; r < 16; ++r) rli[r] = __builtin_amdgcn_rcpf(li_l[crow(r, hi)]);
  if (MODE == 1) {
    bf16* Ow = Ob + (long)(wq * 32) * LDO;
#pragma unroll
    for (int r = 0; r < 16; ++r) { const int orow = crow(r, hi);
#pragma unroll
      for (int d0 = 0; d0 < 4; ++d0) { __hip_bfloat16 bv = __float2bfloat16(o[d0][r] * rli[r]); Ow[(long)orow * LDO + d0 * 32 + r32] = *reinterpret_cast<bf16*>(&bv); } }
  } else {
    __syncthreads();
    float* X = (float*)lds + wq * 4096;
    if (cst == 1) {
#pragma unroll
      for (int r = 0; r < 16; ++r) { const int orow = crow(r, hi);
#pragma unroll
        for (int d0 = 0; d0 < 4; ++d0) X[orow * 128 + d0 * 32 + r32] = o[d0][r] * rli[r]; }
    }
    __syncthreads();
    if (cst == 0) {
      float ssq[16];
#pragma unroll
      for (int r = 0; r < 16; ++r) { const int orow = crow(r, hi); float s = 0.f;
#pragma unroll
        for (int d0 = 0; d0 < 4; ++d0) { const float v = o[d0][r] * rli[r] - lam * X[orow * 128 + d0 * 32 + r32]; o[d0][r] = v; s = fmaf(v, v, s); }
        ssq[r] = s; }
#pragma unroll
      for (int r = 0; r < 16; ++r) {
#pragma unroll
        for (int off = 1; off < 32; off <<= 1) ssq[r] += __shfl_xor(ssq[r], off);
      }
      float gg[4];
#pragma unroll
      for (int d0 = 0; d0 < 4; ++d0) gg[d0] = subg[d0 * 32 + r32] * oscale;
      bf16* Ow = Ob + (long)(wq * 32) * LDO;
#pragma unroll
      for (int r = 0; r < 16; ++r) { const int orow = crow(r, hi); const float rs = __builtin_amdgcn_rsqf(ssq[r] * (1.f / 128.f) + 1e-6f);
#pragma unroll
        for (int d0 = 0; d0 < 4; ++d0) { __hip_bfloat16 bv = __float2bfloat16(o[d0][r] * rs * gg[d0]); Ow[(long)orow * LDO + d0 * 32 + r32] = *reinterpret_cast<bf16*>(&bv); } }
    }
  }
  __builtin_amdgcn_s_setprio(0);
#undef SLOAD
#undef SWRITE
#undef SWAIT
#undef RESC
#undef BIAS
}
#undef SBAR
}

#define LAS __attribute__((address_space(3)))
typedef unsigned short bf16;
typedef unsigned v4u __attribute__((ext_vector_type(4)));
typedef float f32x4 __attribute__((ext_vector_type(4)));
constexpr int NWAVES = 8;
constexpr int DM = 2048, SEQ_P = 8192, NB_P = 4, SEQ_S = 4096, NB_S = 2, DEPTH = 2, DFF = 8192, INW = 4608;
constexpr int M_P = NB_P * SEQ_P, M_S = NB_S * SEQ_S, M = M_P + M_S;
constexpr size_t MiB = 1u << 20;
constexpr size_t WS_WIN = 1 * MiB;
constexpr size_t WS_WOUT = WS_WIN + (size_t)DEPTH * INW * DM * 2;
constexpr size_t WS_WF1 = WS_WOUT + (size_t)DEPTH * DM * DM * 2;
constexpr size_t WS_WF2 = WS_WF1 + (size_t)DEPTH * DFF * DM * 2;
constexpr size_t WS_XN = WS_WF2 + (size_t)DEPTH * DM * DFF * 2;
constexpr size_t WS_H = WS_XN + (size_t)M * DM * 2;
constexpr size_t WS_PROJ = WS_H;
constexpr size_t WS_ATT = WS_PROJ + (size_t)M * INW * 2;
constexpr size_t WS_END = WS_H + (size_t)M * DFF * 2;
static_assert(WS_ATT + (size_t)M * DM * 2 <= WS_END, "overlay");
constexpr int LDS_BYTES = 147456;
static_assert(att::ATT_LDS <= 131072, "attention LDS");

__device__ __forceinline__ unsigned f2bf(float f) { unsigned u = __builtin_bit_cast(unsigned, f); return (u + 0x7fffu + ((u >> 16) & 1u)) >> 16; }
__device__ __forceinline__ unsigned pk2(float lo, float hi) { return f2bf(lo) | (f2bf(hi) << 16); }
__device__ __forceinline__ float wave_sum(float v) {
#pragma unroll
    for (int o = 1; o < 64; o <<= 1) v += __shfl_xor(v, o);
    return v;
}
__device__ __forceinline__ void transpose_item(const float* W, int K, int N, bf16* WT, LAS float* scr, int item, int lane) {
    const int nblk = N / 32, kb = item / nblk, nb = item % nblk, k0 = 64 * kb, n0 = 32 * nb;
#pragma unroll 16
    for (int i = 0; i < 32; ++i) { const int kk = 2 * i + (lane >> 5); scr[kk * 33 + (lane & 31)] = W[(size_t)(k0 + kk) * N + n0 + (lane & 31)]; }
    asm volatile("s_waitcnt lgkmcnt(0)" ::: "memory");
    const int c = lane & 7;
#pragma unroll
    for (int j = 0; j < 4; ++j) { const int n = (lane >> 3) + 8 * j; const LAS float* s = scr + (8 * c) * 33 + n;
        v4u o; o.x = pk2(s[0 * 33], s[1 * 33]); o.y = pk2(s[2 * 33], s[3 * 33]); o.z = pk2(s[4 * 33], s[5 * 33]); o.w = pk2(s[6 * 33], s[7 * 33]);
        *(v4u*)(WT + (size_t)(n0 + n) * K + k0 + 8 * c) = o; }
    asm volatile("s_waitcnt lgkmcnt(0)" ::: "memory");
}
__device__ __forceinline__ float xg_row_bf16(const float* xrow, const float* g, bf16* orow, int lane) {
    const f32x4* xr = (const f32x4*)xrow + lane; const f32x4* gr = (const f32x4*)g + lane;
    f32x4 v[8]; float s = 0.f;
#pragma unroll
    for (int j = 0; j < 8; ++j) { v[j] = xr[64 * j]; s += (v[j].x * v[j].x + v[j].y * v[j].y) + (v[j].z * v[j].z + v[j].w * v[j].w); }
    unsigned long long* o8 = (unsigned long long*)orow + lane;
#pragma unroll
    for (int j = 0; j < 8; ++j) { const f32x4 gg = gr[64 * j]; o8[64 * j] = (unsigned long long)pk2(v[j].x * gg.x, v[j].y * gg.y) | ((unsigned long long)pk2(v[j].z * gg.z, v[j].w * gg.w) << 32); }
    return wave_sum(s);
}
struct Args { const float* in[16]; float* out; unsigned char* ws; int ph_lo, ph_hi; };
constexpr int N_PHASES = 2 + 5 * DEPTH;
constexpr size_t WS_SSQ = 0;

__global__ void __launch_bounds__(NWAVES * 64, 2) mega_fwd(Args args) {
    extern __shared__ __attribute__((aligned(16))) unsigned char lds[];
    cg::grid_group grid = cg::this_grid();
    const int tid = threadIdx.x, wave = __builtin_amdgcn_readfirstlane(tid >> 6); int lane = tid & 63;
#define LAUNDER() asm volatile("" : "+v"(lane))
    const int G = gridDim.x, bx = blockIdx.x;
    const int vcu = (G % 8 == 0) ? (bx % 8) * (G / 8) + bx / 8 : bx;
    const int gw = vcu * NWAVES + wave, NGW = G * NWAVES;
    unsigned char* ws = args.ws;
    const float* x_prompt = args.in[0]; const float* x_sample = args.in[1]; const float* rel_bias = args.in[2];
    const float* norm1_g = args.in[3]; const float* w_in = args.in[4];
    const float* lq1 = args.in[5]; const float* lk1 = args.in[6]; const float* lq2 = args.in[7]; const float* lk2 = args.in[8];
    const float* subln_g = args.in[9]; const float* sink = args.in[10]; const float* w_out = args.in[11]; const float* norm2_g = args.in[12];
    const float* w_f1 = args.in[13]; const float* w_f2 = args.in[14]; const float* fin_g = args.in[15];
    float* out = args.out;
    bf16* Win_t = (bf16*)(ws + WS_WIN); bf16* Wout_t = (bf16*)(ws + WS_WOUT); bf16* Wf1_t = (bf16*)(ws + WS_WF1); bf16* Wf2_t = (bf16*)(ws + WS_WF2);
    float* SSQ = (float*)(ws + WS_SSQ);
    bf16* XN = (bf16*)(ws + WS_XN); bf16* HB = (bf16*)(ws + WS_H); bf16* PROJ = (bf16*)(ws + WS_PROJ); bf16* ATT = (bf16*)(ws + WS_ATT);
    const int lo = args.ph_lo, hi = args.ph_hi;
#define IN(k) (lo <= (k) && (k) < hi)
#define SEAM(k) do { if (IN(k) && IN((k) + 1)) grid.sync(); } while (0)

    if (IN(0)) {
        LAUNDER();
        LAS float* scr = (LAS float*)((LAS unsigned char*)lds + wave * 16384);
        constexpr int I_IN = (DM / 64) * (INW / 32), I_OUT = (DM / 64) * (DM / 32), I_F1 = (DM / 64) * (DFF / 32), I_F2 = (DFF / 64) * (DM / 32);
        constexpr int I_L = I_IN + I_OUT + I_F1 + I_F2;
        for (int it = gw; it < DEPTH * I_L; it += NGW) {
            const int l = it / I_L; int r = it % I_L;
            if (r < I_IN) { transpose_item(w_in + (size_t)l * DM * INW, DM, INW, Win_t + (size_t)l * INW * DM, scr, r, lane); continue; } r -= I_IN;
            if (r < I_OUT) { transpose_item(w_out + (size_t)l * DM * DM, DM, DM, Wout_t + (size_t)l * DM * DM, scr, r, lane); continue; } r -= I_OUT;
            if (r < I_F1) { transpose_item(w_f1 + (size_t)l * DM * DFF, DM, DFF, Wf1_t + (size_t)l * DFF * DM, scr, r, lane); continue; } r -= I_F1;
            transpose_item(w_f2 + (size_t)l * DFF * DM, DFF, DM, Wf2_t + (size_t)l * DM * DFF, scr, r, lane);
        }
        for (int i = (vcu * NWAVES * 64 + tid); i < 4 * M; i += G * NWAVES * 64) SSQ[M + i] = 0.f;
        for (int m = gw; m < M; m += NGW) { const float* xr = m < M_P ? x_prompt + (size_t)m * DM : x_sample + (size_t)(m - M_P) * DM; const float sq = xg_row_bf16(xr, norm1_g, XN + (size_t)m * DM, lane); if (lane == 0) SSQ[m] = sq; }
    }
    SEAM(0);
#pragma unroll
    for (int l = 0; l < DEPTH; ++l) {
        const int pb = 1 + 5 * l;
        if (IN(pb)) {
            pg8::Gemm g{XN, Win_t + (size_t)l * INW * DM, M, INW, DM}; pg8::StaticOrder S; S.init(M, INW, G, bx);
            pg8::EpiBf16<0> E{PROJ, INW, SSQ + (size_t)(2 * l) * M};
            pg8::gemm_phase<pg8::EpiBf16<0>, pg8::StaticOrder, true, true>((LAS unsigned char*)lds, g, S, E);
        }
        SEAM(pb);
        if (IN(pb + 1)) {
            LAUNDER();
            const float lambda_init = 0.8f - 0.6f * expf(-0.3f * (float)l);
            float d1 = lq1[l * 64 + lane] * lk1[l * 64 + lane], d2 = lq2[l * 64 + lane] * lk2[l * 64 + lane];
            d1 = wave_sum(d1); d2 = wave_sum(d2);
            const float lam = expf(d1) - expf(d2) + lambda_init;
#pragma unroll 1
            for (int U = vcu; U < 2560; U += G) {
                int pair, qb, S; size_t row0;
                if (U < 2048) { const int r = U >> 8, v = U & 255, x = v >> 5, cu = v & 31; pair = x * 4 + (r >> 1); qb = (r & 1) * 32 + cu; S = SEQ_P; row0 = (size_t)(pair >> 3) * SEQ_P; }
                else { const int U2 = U - 2048; const int r = U2 >> 8, v = U2 & 255, x = v >> 5, cu = v & 31; pair = x * 2 + r; qb = cu; S = SEQ_S; row0 = (size_t)M_P + (size_t)(pair >> 3) * SEQ_S; }
                const int h = pair & 7;
                if (false) att::attn_unit<0, 0>(PROJ + (row0 + qb * 128) * INW + h * 128, PROJ + row0 * INW + 1024 + h * 128, PROJ + row0 * INW + 2048 + h * 128,
                                  ATT + (row0 + qb * 128) * DM + h * 128, qb * 128, 0, S / 64, rel_bias + h, 0.f, lam, 1.f - lambda_init, subln_g + l * 128, (char*)lds);
                else att::attn_unit<0, 1>(PROJ + (row0 + qb * 128) * INW + h * 128, PROJ + row0 * INW + 1024 + h * 128, PROJ + row0 * INW + 2048 + h * 128,
                                  ATT + (row0 + qb * 128) * DM + h * 128, qb * 128, 0, S / 64, rel_bias + h, 0.f, lam, 1.f - lambda_init, subln_g + l * 128, (char*)lds);
            }
#pragma unroll 1
            for (int U3 = vcu; U3 < 1280; U3 += G) {
                const int r = U3 >> 8, v = U3 & 255; const int w = v * 5 + r; const int rbk = w >> 3, hq = w & 7, kvh = hq >> 2;
                const size_t grow = (size_t)rbk * 256;
                const bool isP = grow < (size_t)M_P; const int S = isP ? SEQ_P : SEQ_S;
                const size_t row0 = isP ? (grow / SEQ_P) * SEQ_P : (size_t)M_P + ((grow - M_P) / SEQ_S) * SEQ_S;
                const int q0 = (int)(grow - row0);
                const int kb = q0 - 128 < 0 ? 0 : q0 - 128, ke = q0 + 384 > S ? S : q0 + 384;
                if (false) att::attn_unit<1, 0>(PROJ + grow * INW + 3072 + hq * 128, PROJ + row0 * INW + 4096 + kvh * 128, PROJ + row0 * INW + 4352 + kvh * 128,
                                  ATT + grow * DM + 1024 + hq * 128, q0, kb, (ke - kb) / 64, rel_bias + 8 + hq, sink[l * 8 + hq], 0.f, 1.f, nullptr, (char*)lds);
                else att::attn_unit<1, 1>(PROJ + grow * INW + 3072 + hq * 128, PROJ + row0 * INW + 4096 + kvh * 128, PROJ + row0 * INW + 4352 + kvh * 128,
                                  ATT + grow * DM + 1024 + hq * 128, q0, kb, (ke - kb) / 64, rel_bias + 8 + hq, sink[l * 8 + hq], 0.f, 1.f, nullptr, (char*)lds);
            }
            __syncthreads();
        }
        SEAM(pb + 1);
        if (IN(pb + 2)) {
            pg8::Gemm g{ATT, Wout_t + (size_t)l * DM * DM, M, DM, DM}; pg8::StaticOrder S; S.init(M, DM, G, bx);
            pg8::EpiResF32 E{l == 0 ? x_prompt : out, l == 0 ? x_sample : out + (size_t)M_P * DM, M_P, out, XN, norm2_g + l * DM, SSQ + (size_t)(2 * l + 1) * M};
            pg8::gemm_phase<pg8::EpiResF32, pg8::StaticOrder, true, true>((LAS unsigned char*)lds, g, S, E);
        }
        SEAM(pb + 2);
        if (IN(pb + 3)) {
            pg8::Gemm g{XN, Wf1_t + (size_t)l * DFF * DM, M, DFF, DM}; pg8::StaticOrder S; S.init(M, DFF, G, bx);
            pg8::EpiBf16<1> E{HB, DFF, SSQ + (size_t)(2 * l + 1) * M};
            pg8::gemm_phase<pg8::EpiBf16<1>, pg8::StaticOrder, true, true>((LAS unsigned char*)lds, g, S, E);
        }
        SEAM(pb + 3);
        if (IN(pb + 4)) {
            pg8::Gemm g{HB, Wf2_t + (size_t)l * DM * DFF, M, DM, DFF}; pg8::StaticOrder S; S.init(M, DM, G, bx);
            pg8::EpiResF32 E{out, out + (size_t)M_P * DM, M_P, out, l + 1 < DEPTH ? XN : nullptr, l + 1 < DEPTH ? norm1_g + (l + 1) * DM : fin_g, SSQ + (size_t)(2 * l + 2) * M};
            pg8::gemm_phase<pg8::EpiResF32, pg8::StaticOrder, true, true>((LAS unsigned char*)lds, g, S, E);
        }
        SEAM(pb + 4);
    }
    if (IN(1 + 5 * DEPTH)) {
        LAUNDER();
        const float* sq = SSQ + (size_t)(2 * DEPTH) * M;
        for (int m = gw; m < M; m += NGW) { f32x4* xr = (f32x4*)(out + (size_t)m * DM) + lane; const f32x4* gr = (const f32x4*)fin_g + lane; const float rs = 1.f / sqrtf(sq[m] * (1.f / DM) + 1e-6f);
#pragma unroll
            for (int j = 0; j < 8; ++j) xr[64 * j] = xr[64 * j] * rs * gr[64 * j]; }
    }
#undef IN
#undef SEAM
}

extern "C" void kernel_launch(void* const* d_in, const int* in_sizes, int n_in, void* d_out, int out_size, void* d_ws, size_t ws_size, hipStream_t stream) {
    static int grid = 0;
    if (grid == 0) {
        if (n_in != 16 || in_sizes[0] != M_P * DM || in_sizes[1] != M_S * DM || out_size != M * DM || ws_size < WS_END) {
            fprintf(stderr, "kernel_launch: shape/workspace mismatch: n_in %d in0 %d in1 %d out %d ws %zu (need %zu)\n", n_in, n_in > 0 ? in_sizes[0] : -1, n_in > 1 ? in_sizes[1] : -1, out_size, ws_size, (size_t)WS_END);
            grid = -1; return; }
        int dev = 0, cus = 0, per_cu = 0;
        hipGetDevice(&dev); hipDeviceGetAttribute(&cus, hipDeviceAttributeMultiprocessorCount, dev);
        if (hipFuncSetAttribute((const void*)mega_fwd, hipFuncAttributeMaxDynamicSharedMemorySize, LDS_BYTES) != hipSuccess) { fprintf(stderr, "kernel_launch: hipFuncSetAttribute failed\n"); grid = -1; return; }
        if (hipOccupancyMaxActiveBlocksPerMultiprocessor(&per_cu, (const void*)mega_fwd, NWAVES * 64, LDS_BYTES) != hipSuccess || per_cu < 1) { fprintf(stderr, "kernel_launch: occupancy query gave %d\n", per_cu); per_cu = 1; }
        (void)hipGetLastError();
        grid = cus * per_cu;
    }
    if (grid < 0) return;
    Args a{};
    for (int i = 0; i < 16; ++i) a.in[i] = (const float*)d_in[i];
    a.out = (float*)d_out; a.ws = (unsigned char*)d_ws;
#if MK_MULTI
    for (int p = 0; p < N_PHASES; ++p) { a.ph_lo = p; a.ph_hi = p + 1; void* kargs[] = {&a};
        hipError_t e = hipLaunchCooperativeKernel((const void*)mega_fwd, dim3(grid), dim3(NWAVES * 64), kargs, LDS_BYTES, stream);
        if (e != hipSuccess) { fprintf(stderr, "kernel_launch: launch %d failed: %s (grid %d)\n", p, hipGetErrorString(e), grid); break; } }
#else
    a.ph_lo = 0; a.ph_hi = N_PHASES; void* kargs[] = {&a};
    hipError_t e = hipLaunchCooperativeKernel((const void*)mega_fwd, dim3(grid), dim3(NWAVES * 64), kargs, LDS_BYTES, stream);
    if (e != hipSuccess) fprintf(stderr, "kernel_launch: cooperative launch failed: %s (grid %d)\n", hipGetErrorString(e), grid);
#endif
}
```

```cpp
#include <hip/hip_runtime.h>
#include <hip/hip_bf16.h>
#include <hip/hip_cooperative_groups.h>
#include <cstdio>
#include <cstdint>
namespace cg = cooperative_groups;

#ifndef MK_MULTI
#define MK_MULTI 0
#endif


namespace pg8 {
#define PG8_LAS __attribute__((address_space(3)))
typedef unsigned short bf16_t;
typedef short bf16x8 __attribute__((ext_vector_type(8)));
typedef float f32x4 __attribute__((ext_vector_type(4)));
typedef unsigned u32x4 __attribute__((ext_vector_type(4)));
constexpr int BM = 256, BK = 64, HALF = 128, HTB = HALF * BK * 2  , STAGE_BYTES = 8 * HTB, NXCD = 8, WGM = 8;

__host__ __device__ __forceinline__ int lds_byte(int r, int c) { const int st = (r >> 4) * 2 + (c >> 5), rr = r & 15, cc = c & 31, ob = rr * 64 + cc * 2; return st * 1024 + (ob ^ (((ob >> 9) & 1) << 5)); }
__host__ __device__ __forceinline__ void stage_rc(int b, int& R, int& C) { const int st = b / 1024, sb = b % 1024, swz = sb ^ (((sb >> 9) & 1) << 5); R = (st >> 1) * 16 + swz / 64; C = (st & 1) * 32 + (swz % 64) / 2; }
__host__ __device__ __forceinline__ int perm32(int rho) { const int n = rho >> 4, i = rho & 15; return 8 * (i >> 2) + 4 * n + (i & 3); }

struct Unit { int pm, pn; };
struct Gemm { const bf16_t* A; const bf16_t* Bt; int M, N, K; };

struct StaticOrder {
    int nM, nN, nwg, G, c;
    __host__ __device__ void init(int M, int N, int G_, int c_) { nM = M / BM; nN = N / BM; nwg = nM * nN; G = G_; c = c_; }
    __host__ __device__ bool next(int i, Unit& u) const {
        const long L = (long)i * G + c; if (L >= nwg) return false;
        int wgid = (int)L; { const int q = nwg / NXCD, r = nwg % NXCD, xcd = wgid % NXCD, off = wgid / NXCD; wgid = (xcd < r ? xcd * (q + 1) : r * (q + 1) + (xcd - r) * q) + off; }
        const int nig = WGM * nN, gid = wgid / nig, fm = gid * WGM, gsz = (nM - fm) < WGM ? (nM - fm) : WGM;
        u.pm = fm + ((wgid % nig) % gsz); u.pn = (wgid % nig) / gsz; return true;
    }
    __device__ __forceinline__ void a_ready(const Unit&) const {}
    __device__ __forceinline__ void done(const Unit&) const {}
};

typedef unsigned u32x4 __attribute__((ext_vector_type(4)));
__device__ __forceinline__ unsigned cvt_pk_bf16(float lo, float hi) { unsigned r; asm volatile("v_cvt_pk_bf16_f32 %0, %1, %2" : "=v"(r) : "v"(lo), "v"(hi)); return r; }

template <int ACT  > struct EpiBf16 {
    static constexpr bool PERM = true, AFTER_DRAIN = false;
    bf16_t* O; int ldc; const float* ssq;
    __device__ __forceinline__ void operator()(const f32x4 (&acc)[2][2][4][2], const Unit& u, int wr, int wc, int fr, int fq) const {
        asm volatile("" : "+v"(fr), "+v"(fq));
        const int row0 = u.pm * BM + wr * 64 + fr; const int col0 = u.pn * BM + wc * 32 + 8 * fq;
#pragma unroll
        for (int ai = 0; ai < 2; ++ai)
#pragma unroll
            for (int m = 0; m < 4; ++m) { const int row = row0 + ai * HALF + m * 16; bf16_t* rowp = O + (size_t)row * ldc + col0;
                const float rs = __builtin_amdgcn_rsqf(ssq[row] * (1.f / 2048.f) + 1e-6f);
#pragma unroll
                for (int bj = 0; bj < 2; ++bj) { f32x4 v0 = acc[ai][bj][m][0] * rs, v1 = acc[ai][bj][m][1] * rs;
                    if (ACT == 1) {
#pragma unroll
                        for (int e = 0; e < 4; ++e) { float a = fmaxf(v0[e], 0.f), b = fmaxf(v1[e], 0.f); v0[e] = a * a; v1[e] = b * b; } }
                    u32x4 w; w.x = cvt_pk_bf16(v0[0], v0[1]); w.y = cvt_pk_bf16(v0[2], v0[3]); w.z = cvt_pk_bf16(v1[0], v1[1]); w.w = cvt_pk_bf16(v1[2], v1[3]);
                    __builtin_nontemporal_store(w, (u32x4*)(rowp + bj * HALF)); } }
    }
};
struct EpiResF32 {
    static constexpr bool PERM = true, AFTER_DRAIN = false;
    const float* b0; const float* b1; int split; float* out; bf16_t* xn; const float* g; float* ssq;
    __device__ __forceinline__ void operator()(const f32x4 (&acc)[2][2][4][2], const Unit& u, int wr, int wc, int fr, int fq) const {
        asm volatile("" : "+v"(fr), "+v"(fq));
        const int col0 = u.pn * BM + wc * 32 + 8 * fq;
        const int rt = u.pm * BM; const float* bb = (rt < split) ? b0 + (size_t)rt * 2048 : b1 + (size_t)(rt - split) * 2048; float* oo = out + (size_t)rt * 2048; bf16_t* xx = xn + (size_t)rt * 2048;
        float sacc[2][4];
        f32x4 gv[2][2];
#pragma unroll
        for (int bj = 0; bj < 2; ++bj) { gv[bj][0] = *(const f32x4*)(g + col0 + bj * HALF); gv[bj][1] = *(const f32x4*)(g + col0 + bj * HALF + 4); }
#pragma unroll
        for (int ai = 0; ai < 2; ++ai) {
            f32x4 pre[4][2][2];
#pragma unroll
            for (int m = 0; m < 4; ++m) { const size_t off = (size_t)(ai * HALF + wr * 64 + m * 16 + fr) * 2048 + col0;
#pragma unroll
                for (int bj = 0; bj < 2; ++bj) { pre[m][bj][0] = *(const f32x4*)(bb + off + bj * HALF); pre[m][bj][1] = *(const f32x4*)(bb + off + bj * HALF + 4); } }
            asm volatile("" ::: "memory");
#pragma unroll
            for (int m = 0; m < 4; ++m) { const int rl = ai * HALF + wr * 64 + m * 16 + fr; const size_t off = (size_t)rl * 2048 + col0; float s = 0.f;
#pragma unroll
                for (int bj = 0; bj < 2; ++bj) {
                    const f32x4 v0 = pre[m][bj][0] + acc[ai][bj][m][0], v1 = pre[m][bj][1] + acc[ai][bj][m][1];
                    *(f32x4*)(oo + off + bj * HALF) = v0; *(f32x4*)(oo + off + bj * HALF + 4) = v1;
                    s += (v0[0] * v0[0] + v0[1] * v0[1]) + (v0[2] * v0[2] + v0[3] * v0[3]) + (v1[0] * v1[0] + v1[1] * v1[1]) + (v1[2] * v1[2] + v1[3] * v1[3]);
                    const f32x4 a = v0 * gv[bj][0], b = v1 * gv[bj][1];
                    u32x4 w; w.x = cvt_pk_bf16(a[0], a[1]); w.y = cvt_pk_bf16(a[2], a[3]); w.z = cvt_pk_bf16(b[0], b[1]); w.w = cvt_pk_bf16(b[2], b[3]);
                    if (xn) *(u32x4*)(xx + off + bj * HALF) = w; }
                s += __shfl_xor(s, 16); s += __shfl_xor(s, 32); sacc[ai][m] = s; }
            asm volatile("" ::: "memory");
        }
        if (fq == 0) {
#pragma unroll
            for (int ai = 0; ai < 2; ++ai)
#pragma unroll
                for (int m = 0; m < 4; ++m) atomicAdd(ssq + rt + ai * HALF + wr * 64 + m * 16 + fr, sacc[ai][m]); }
    }
};
template <class Epi, class Sched, bool ALIGN_EPI = false, bool SP2 = false>
__device__ __forceinline__ void gemm_phase(PG8_LAS unsigned char* lds, const Gemm g, const Sched& S, const Epi& E) {
    int tid_ = threadIdx.x; asm volatile("" : "+v"(tid_));
    const int tid = tid_, wid = __builtin_amdgcn_readfirstlane(tid >> 6), lane = tid & 63, wr = wid >> 2, wc = wid & 3, fr = lane & 15, fq = lane >> 4;
    const int K = g.K, nt = K / BK;
    unsigned voffA[2], voffB[2];
#pragma unroll
    for (int i = 0; i < 2; ++i) { int R, C; stage_rc(tid * 16 + i * 8192, R, C); const int Rb = Epi::PERM ? ((R & ~31) + perm32(R & 31)) : R;
        voffA[i] = (unsigned)(R * K + C) * 2u; voffB[i] = (unsigned)(Rb * K + C) * 2u; }
    const size_t kstep = (size_t)(BK * 2);
    const size_t hstep = (size_t)HALF * K * 2;
    const size_t tstep = 2 * hstep;
    const unsigned ldsw = (unsigned)wid * 1024u;
    const int aoff = lds_byte(wr * 64 + fr, fq * 8), boff = lds_byte(wc * 32 + fr, fq * 8);
#define PG8_SA(b, h) (((b) * 2 + (h)) * HTB)
#define PG8_SB(b, h) ((4 + (b) * 2 + (h)) * HTB)
#define PG8_STAGE(bufoff, gbase, voff) do { _Pragma("unroll") for (int _i = 0; _i < 2; ++_i) \
        __builtin_amdgcn_global_load_lds((const unsigned*)((const char*)(gbase) + (voff)[_i]), (PG8_LAS unsigned*)(lds + (bufoff) + ldsw + _i * 8192), 16, 0, 0); } while (0)
#define PG8_LDA(dst, b, h) do { _Pragma("unroll") for (int m = 0; m < 4; ++m) _Pragma("unroll") for (int k = 0; k < 2; ++k) dst[m][k] = *(const PG8_LAS bf16x8*)(lds + PG8_SA(b, h) + aoff + m * 2048 + k * 1024); } while (0)
#define PG8_LDB(dst, b, h) do { _Pragma("unroll") for (int n = 0; n < 2; ++n) _Pragma("unroll") for (int k = 0; k < 2; ++k) dst[n][k] = *(const PG8_LAS bf16x8*)(lds + PG8_SB(b, h) + boff + n * 2048 + k * 1024); } while (0)
#define PG8_MMA(ai, bj, At, Bt) do { __builtin_amdgcn_s_setprio(1); _Pragma("unroll") for (int m = 0; m < 4; ++m) _Pragma("unroll") for (int n = 0; n < 2; ++n) _Pragma("unroll") for (int k = 0; k < 2; ++k) \
        acc[ai][bj][m][n] = __builtin_amdgcn_mfma_f32_16x16x32_bf16(Bt[n][k], At[m][k], acc[ai][bj][m][n], 0, 0, 0); __builtin_amdgcn_s_setprio(0); } while (0)
#define PG8_WAIT_V(n) asm volatile("s_waitcnt vmcnt(" #n ")" ::: "memory")
#define PG8_WAIT_L(n) asm volatile("s_waitcnt lgkmcnt(" #n ")" ::: "memory")
#define PG8_BAR __builtin_amdgcn_s_barrier()
#define PG8_SCHED __builtin_amdgcn_sched_barrier(0)
    Unit cur, nxt; int ui = 0;
    if (!S.next(0, cur)) return;
    f32x4 acc[2][2][4][2];
#pragma unroll
    for (int a = 0; a < 2; ++a)
#pragma unroll
        for (int b = 0; b < 2; ++b)
#pragma unroll
            for (int m = 0; m < 4; ++m)
#pragma unroll
                for (int n = 0; n < 2; ++n) acc[a][b][m][n] = (f32x4){0.f, 0.f, 0.f, 0.f};
    bf16x8 At[4][2], B0[2][2], B1[2][2];
    const char* cA = (const char*)g.A + (size_t)cur.pm * tstep; const char* cB = (const char*)g.Bt + (size_t)cur.pn * tstep;
    S.a_ready(cur);
    if constexpr (SP2) {
        PG8_STAGE(PG8_SB(0, 0), cB, voffB); PG8_STAGE(PG8_SB(0, 1), cB + hstep, voffB); PG8_STAGE(PG8_SA(0, 0), cA, voffA); PG8_STAGE(PG8_SA(0, 1), cA + hstep, voffA);
        if (wr == 1) PG8_BAR;
        PG8_WAIT_V(2); PG8_BAR;
        PG8_STAGE(PG8_SB(1, 0), cB + kstep, voffB); PG8_STAGE(PG8_SA(1, 0), cA + kstep, voffA); PG8_STAGE(PG8_SB(1, 1), cB + hstep + kstep, voffB);
        PG8_WAIT_V(6); PG8_BAR;
    } else {
        PG8_STAGE(PG8_SB(0, 0), cB, voffB); PG8_STAGE(PG8_SA(0, 0), cA, voffA); PG8_STAGE(PG8_SB(0, 1), cB + hstep, voffB); PG8_STAGE(PG8_SA(0, 1), cA + hstep, voffA);
        if (wr == 1) PG8_BAR;
        PG8_WAIT_V(4); PG8_BAR;
        PG8_STAGE(PG8_SB(1, 0), cB + kstep, voffB); PG8_STAGE(PG8_SA(1, 0), cA + kstep, voffA); PG8_STAGE(PG8_SB(1, 1), cB + hstep + kstep, voffB);
        PG8_WAIT_V(6); PG8_BAR;
    }
    for (;;) {
        const bool has_next = S.next(ui + 1, nxt);
        const char* nA = has_next ? (const char*)g.A + (size_t)nxt.pm * tstep : cA; const char* nB = has_next ? (const char*)g.Bt + (size_t)nxt.pn * tstep : cB;
        for (int t = 0; t < nt; t += 2) {
            const bool last = (t == nt - 2);
            const char* a1 = cA + (size_t)(t + 1) * kstep;
            const char* a2 = last ? nA : cA + (size_t)(t + 2) * kstep; const char* b2 = last ? nB : cB + (size_t)(t + 2) * kstep;
            const char* a3 = a2 + kstep; const char* b3 = b2 + kstep;
            if (last && has_next) S.a_ready(nxt);
            if constexpr (SP2) {
            PG8_LDB(B0, 0, 0); PG8_LDB(B1, 0, 1); PG8_SCHED; PG8_LDA(At, 0, 0); PG8_STAGE(PG8_SA(1, 1), a1 + hstep, voffA);
            PG8_WAIT_V(8); PG8_WAIT_L(0); PG8_BAR; PG8_MMA(0, 0, At, B0); PG8_MMA(0, 1, At, B1); PG8_BAR; PG8_SCHED;
            PG8_LDA(At, 0, 1); PG8_STAGE(PG8_SB(0, 0), b2, voffB); PG8_STAGE(PG8_SB(0, 1), b2 + hstep, voffB); PG8_STAGE(PG8_SA(0, 0), a2, voffA);
            PG8_WAIT_V(8); PG8_WAIT_L(0); PG8_BAR; PG8_MMA(1, 0, At, B0); PG8_MMA(1, 1, At, B1); PG8_BAR; PG8_SCHED;
            PG8_LDB(B0, 1, 0); PG8_LDB(B1, 1, 1); PG8_SCHED; PG8_LDA(At, 1, 0); PG8_STAGE(PG8_SA(0, 1), a2 + hstep, voffA);
            PG8_WAIT_V(8); PG8_WAIT_L(0); PG8_BAR; PG8_MMA(0, 0, At, B0); PG8_MMA(0, 1, At, B1); PG8_BAR; PG8_SCHED;
            PG8_LDA(At, 1, 1); PG8_STAGE(PG8_SB(1, 0), b3, voffB); PG8_STAGE(PG8_SB(1, 1), b3 + hstep, voffB); PG8_STAGE(PG8_SA(1, 0), a3, voffA);
            PG8_WAIT_V(8); PG8_WAIT_L(0); PG8_BAR; PG8_MMA(1, 0, At, B0); PG8_MMA(1, 1, At, B1); PG8_BAR; PG8_SCHED;
            } else {
            PG8_LDB(B0, 0, 0); PG8_SCHED; PG8_LDA(At, 0, 0); PG8_STAGE(PG8_SA(1, 1), a1 + hstep, voffA);
            PG8_WAIT_L(8); PG8_BAR; PG8_WAIT_L(0); PG8_MMA(0, 0, At, B0); PG8_BAR; PG8_SCHED;
            PG8_LDB(B1, 0, 1); PG8_STAGE(PG8_SB(0, 0), b2, voffB);
            PG8_BAR; PG8_WAIT_L(0); PG8_MMA(0, 1, At, B1); PG8_BAR;
            PG8_LDA(At, 0, 1); PG8_STAGE(PG8_SA(0, 0), a2, voffA);
            PG8_BAR; PG8_WAIT_L(0); PG8_MMA(1, 0, At, B0); PG8_BAR; PG8_SCHED;
            PG8_STAGE(PG8_SB(0, 1), b2 + hstep, voffB);
            PG8_WAIT_V(6); PG8_BAR; PG8_MMA(1, 1, At, B1); PG8_BAR;
            PG8_LDB(B0, 1, 0); PG8_SCHED; PG8_LDA(At, 1, 0); PG8_STAGE(PG8_SA(0, 1), a2 + hstep, voffA);
            PG8_WAIT_L(8); PG8_BAR; PG8_WAIT_L(0); PG8_MMA(0, 0, At, B0); PG8_BAR; PG8_SCHED;
            PG8_LDB(B1, 1, 1); PG8_STAGE(PG8_SB(1, 0), b3, voffB);
            PG8_BAR; PG8_WAIT_L(0); PG8_MMA(0, 1, At, B1); PG8_BAR;
            PG8_LDA(At, 1, 1); PG8_STAGE(PG8_SA(1, 0), a3, voffA);
            PG8_BAR; PG8_WAIT_L(0); PG8_MMA(1, 0, At, B0); PG8_BAR; PG8_SCHED;
            PG8_STAGE(PG8_SB(1, 1), b3 + hstep, voffB);
            PG8_WAIT_V(6); PG8_BAR; PG8_MMA(1, 1, At, B1); PG8_BAR;
            }
        }
        if constexpr (ALIGN_EPI) { if (wr == 0) PG8_BAR; }
        if constexpr (!Epi::AFTER_DRAIN) { E(acc, cur, wr, wc, fr, fq); S.done(cur); }
        if (!has_next) break;
#pragma unroll
        for (int a = 0; a < 2; ++a)
#pragma unroll
            for (int b = 0; b < 2; ++b)
#pragma unroll
                for (int m = 0; m < 4; ++m)
#pragma unroll
                    for (int n = 0; n < 2; ++n) acc[a][b][m][n] = (f32x4){0.f, 0.f, 0.f, 0.f};
        cur = nxt; cA = nA; cB = nB; ++ui;
        if constexpr (ALIGN_EPI) { if (wr == 1) PG8_BAR; }
    }
    PG8_WAIT_V(0);
    if constexpr (!ALIGN_EPI) { if (wr == 0) PG8_BAR; }
    PG8_BAR;
    if constexpr (Epi::AFTER_DRAIN) { E.fused(acc, cur, wr, wc, fr, fq, lds, wid, lane); S.done(cur); }
#undef PG8_SA
#undef PG8_SB
#undef PG8_STAGE
#undef PG8_LDA
#undef PG8_LDB
#undef PG8_MMA
#undef PG8_WAIT_V
#undef PG8_WAIT_L
#undef PG8_BAR
#undef PG8_SCHED
}
}
namespace att {
using bf16 = unsigned short;
using bf16x8 = __attribute__((ext_vector_type(8))) short;
using s16x4  = __attribute__((ext_vector_type(4))) short;
using f32x16 = __attribute__((ext_vector_type(16))) float;
using u32x4  = __attribute__((ext_vector_type(4))) unsigned;
constexpr int KVBLK = 64, LDP = 4608, LDO = 2048;
constexpr int SHM_V = 16384, SHM_K = 16384;
constexpr int SLOT = SHM_V + SHM_K, NSLOT = 3;
constexpr int OFF_V = 0, OFF_K = SHM_V, OFF_WS = NSLOT * SLOT, OFF_TAB = OFF_WS + 8 * 64 * 4, ATT_LDS = OFF_TAB + 272 * 4;
constexpr float LOG2E = 1.4426950408889634f;
constexpr float THR = 8.f;
constexpr float NEGB = -1e30f;
#define KSWZ(row, colB) ((row) * 256 + ((colB) ^ (((row) & 7) << 4)))
#define SBAR() __builtin_amdgcn_sched_barrier(0)
__device__ __forceinline__ int crow(int r, int hi) { return (r & 3) + 8 * (r >> 2) + 4 * hi; }
__device__ __forceinline__ unsigned cvtpk(float lo, float hi) { unsigned r; asm volatile("v_cvt_pk_bf16_f32 %0, %1, %2" : "=v"(r) : "v"(lo), "v"(hi)); return r; }
__device__ __forceinline__ bf16x8 ld8(const bf16* p) { return *reinterpret_cast<const bf16x8*>(p); }

__device__ __forceinline__ float max3f(float a, float b, float c) { float r; asm("v_max3_f32 %0, %1, %2, %3" : "=v"(r) : "v"(a), "v"(b), "v"(c)); return r; }
__device__ __forceinline__ int t5_bucket(int rel) {
  const int n = rel < 0 ? -rel : rel; int b;
  if (n < 8) b = n; else { int l = (31 - __builtin_clz((unsigned)(n * n))) - 6; b = 8 + l; if (b > 15) b = 15; }
  return (rel > 0 ? 16 : 0) + b;
}

__device__ __forceinline__ void partialSM(f32x16& p0, f32x16& p1, float& m_reg, float& alpha, float Ce, float be) {
  float pmax = max3f(p0[0], p0[1], p1[0]), pmb = max3f(p0[2], p0[3], p1[1]);
  pmax = max3f(pmax, p1[2], p1[3]);
#pragma unroll
  for (int r = 4; r < 16; r += 4) { pmax = max3f(pmax, p0[r], p0[r + 1]); pmb = max3f(pmb, p0[r + 2], p0[r + 3]); pmax = max3f(pmax, p1[r], p1[r + 1]); pmb = max3f(pmb, p1[r + 2], p1[r + 3]); }
  pmax = max3f(pmax, pmb, pmb);
  { auto rr = __builtin_amdgcn_permlane32_swap(__float_as_uint(pmax), __float_as_uint(pmax), false, false);
    pmax = fmaxf(__uint_as_float(rr[0]), __uint_as_float(rr[1])); }
  pmax = fmaf(pmax, Ce, be);
  float mn;
  if (__builtin_expect(__all(pmax - m_reg <= THR), 1)) { mn = m_reg; alpha = 1.f; }
  else { mn = fmaxf(m_reg, pmax); alpha = __builtin_amdgcn_exp2f(m_reg - mn); m_reg = mn; }
  const float off = be - mn;
#pragma unroll
  for (int r = 0; r < 16; ++r) p0[r] = fmaf(p0[r], Ce, off);
#pragma unroll
  for (int r = 0; r < 16; ++r) p1[r] = fmaf(p1[r], Ce, off);
#pragma unroll
  for (int r = 0; r < 16; ++r) p0[r] = __builtin_amdgcn_exp2f(p0[r]);
}
__device__ __forceinline__ void finishSM(f32x16& p0, f32x16& p1, float alpha, float& l_reg, bf16x8& pa0, bf16x8& pa1, bf16x8& pa2, bf16x8& pa3) {
#pragma unroll
  for (int r = 0; r < 16; ++r) p1[r] = __builtin_amdgcn_exp2f(p1[r]);
  float ps = 0;
#pragma unroll
  for (int r = 0; r < 16; ++r) ps += p0[r];
#pragma unroll
  for (int r = 0; r < 16; ++r) ps += p1[r];
  { auto rr = __builtin_amdgcn_permlane32_swap(__float_as_uint(ps), __float_as_uint(ps), false, false);
    ps = __uint_as_float(rr[0]) + __uint_as_float(rr[1]); }
  l_reg = l_reg * alpha + ps;
#define PK4(P, BASE, OUT) do { unsigned a0 = cvtpk(P[BASE + 0], P[BASE + 1]), a1 = cvtpk(P[BASE + 2], P[BASE + 3]);   \
    unsigned b0 = cvtpk(P[BASE + 4], P[BASE + 5]), b1 = cvtpk(P[BASE + 6], P[BASE + 7]);                              \
    auto r0 = __builtin_amdgcn_permlane32_swap(a0, b0, false, false); auto r1 = __builtin_amdgcn_permlane32_swap(a1, b1, false, false); \
    u32x4 w = {r0[0], r1[0], r0[1], r1[1]}; OUT = *reinterpret_cast<bf16x8*>(&w); } while (0)
  PK4(p0, 0, pa0); PK4(p0, 8, pa1); PK4(p1, 0, pa2); PK4(p1, 8, pa3);
#undef PK4
}
__device__ __forceinline__ bf16x8 scale_bf16x8(bf16x8 v, float c) {
  u32x4 w = *reinterpret_cast<u32x4*>(&v), o;
#pragma unroll
  for (int i = 0; i < 4; ++i) { const float lo = __uint_as_float(w[i] << 16), hh = __uint_as_float(w[i] & 0xffff0000u); o[i] = cvtpk(lo * c, hh * c); }
  return *reinterpret_cast<bf16x8*>(&o);
}
template <int ND0> __device__ __forceinline__ void qkt(f32x16& p0, f32x16& p1, const char* Ks, const bf16x8* qr, int r32, int hi, int cboff, const f32x16& ci) {
#pragma unroll
  for (int d0 = 0; d0 < ND0; ++d0) { int cb = cboff + (d0 * 16 + hi * 8) * 2;
    bf16x8 b0 = *reinterpret_cast<const bf16x8*>(Ks + KSWZ(r32, cb));
    bf16x8 b1 = *reinterpret_cast<const bf16x8*>(Ks + KSWZ(32 + r32, cb));
    if (d0 == 0) { p0 = __builtin_amdgcn_mfma_f32_32x32x16_bf16(b0, qr[0], ci, 0, 0, 0); p1 = __builtin_amdgcn_mfma_f32_32x32x16_bf16(b1, qr[0], ci, 0, 0, 0); }
    else { p0 = __builtin_amdgcn_mfma_f32_32x32x16_bf16(b0, qr[d0], p0, 0, 0, 0); p1 = __builtin_amdgcn_mfma_f32_32x32x16_bf16(b1, qr[d0], p1, 0, 0, 0); } }
}
template <bool FIRST> __device__ __forceinline__ void partialSM2(f32x16& p0, f32x16& p1, float& m_ref, f32x16& negm, float& alpha) {
  float pmax = max3f(p0[0], p0[1], p1[0]), pmb = max3f(p0[2], p0[3], p1[1]);
  pmax = max3f(pmax, p1[2], p1[3]);
#pragma unroll
  for (int r = 4; r < 16; r += 4) { pmax = max3f(pmax, p0[r], p0[r + 1]); pmb = max3f(pmb, p0[r + 2], p0[r + 3]); pmax = max3f(pmax, p1[r], p1[r + 1]); pmb = max3f(pmb, p1[r + 2], p1[r + 3]); }
  pmax = max3f(pmax, pmb, pmb);
  { auto rr = __builtin_amdgcn_permlane32_swap(__float_as_uint(pmax), __float_as_uint(pmax), false, false);
    pmax = fmaxf(__uint_as_float(rr[0]), __uint_as_float(rr[1])); }
  alpha = 1.f;
  if (FIRST || !__builtin_expect(__all(pmax <= THR), 1)) {
    const float dl = FIRST ? pmax : fmaxf(pmax, 0.f); m_ref += dl; if (!FIRST) alpha = __builtin_amdgcn_exp2f(-dl);
#pragma unroll
    for (int r = 0; r < 16; ++r) { p0[r] -= dl; p1[r] -= dl; negm[r] -= dl; }
  }
#pragma unroll
  for (int r = 0; r < 16; ++r) p0[r] = __builtin_amdgcn_exp2f(p0[r]);
}
__device__ __forceinline__ int v_st(int k, int c) { const int kk = (k & ~0xC) | ((k & 4) << 1) | ((k & 8) >> 1); return ((kk >> 3) * 4 + (c >> 5)) * 512 + ((kk & 7) * 32 + (c & 31)) * 2; }
__device__ __forceinline__ int v_rd_base(int lane) { return ((lane & 3) << 3) | (((lane >> 2) & 3) << 6) | (((lane >> 4) & 1) << 5) | (((lane >> 5) & 1) << 8); }
constexpr int v_rd_off(int d0, int ks, int half) { return d0 * 512 + ks * 4096 + half * 2048; }
template <int OFF> __device__ __forceinline__ s16x4 tr_read(int vb) {
  s16x4 r; asm volatile("ds_read_b64_tr_b16 %0, %1 offset:%2" : "=&v"(r) : "v"(vb), "i"(OFF) : "memory"); return r;
}
#define VRD8(D0, L0, H0, L1, H1, L2, H2, L3, H3) do { L0 = tr_read<v_rd_off(D0, 0, 0)>(vb); H0 = tr_read<v_rd_off(D0, 0, 1)>(vb); L1 = tr_read<v_rd_off(D0, 1, 0)>(vb); H1 = tr_read<v_rd_off(D0, 1, 1)>(vb); \
    L2 = tr_read<v_rd_off(D0, 2, 0)>(vb); H2 = tr_read<v_rd_off(D0, 2, 1)>(vb); L3 = tr_read<v_rd_off(D0, 3, 0)>(vb); H3 = tr_read<v_rd_off(D0, 3, 1)>(vb); } while (0)
#define PK(L, H) (bf16x8){L[0], L[1], L[2], L[3], H[0], H[1], H[2], H[3]}
#define MMA4(OD, L0, H0, L1, H1, L2, H2, L3, H3) do { OD = __builtin_amdgcn_mfma_f32_32x32x16_bf16(pa0, PK(L0, H0), OD, 0, 0, 0); OD = __builtin_amdgcn_mfma_f32_32x32x16_bf16(pa1, PK(L1, H1), OD, 0, 0, 0); \
    OD = __builtin_amdgcn_mfma_f32_32x32x16_bf16(pa2, PK(L2, H2), OD, 0, 0, 0); OD = __builtin_amdgcn_mfma_f32_32x32x16_bf16(pa3, PK(L3, H3), OD, 0, 0, 0); } while (0)
__device__ __forceinline__ void pv_d0(f32x16* o, int vb, bf16x8 pa0, bf16x8 pa1, bf16x8 pa2, bf16x8 pa3) {
  s16x4 a0, a1, a2, a3, a4, a5, a6, a7, b0, b1, b2, b3, b4, b5, b6, b7;
  VRD8(0, a0, a1, a2, a3, a4, a5, a6, a7);
  VRD8(1, b0, b1, b2, b3, b4, b5, b6, b7);
  asm volatile("s_waitcnt lgkmcnt(8)" ::: "memory"); SBAR();
  MMA4(o[0], a0, a1, a2, a3, a4, a5, a6, a7); SBAR();
  VRD8(2, a0, a1, a2, a3, a4, a5, a6, a7);
  asm volatile("s_waitcnt lgkmcnt(8)" ::: "memory"); SBAR();
  MMA4(o[1], b0, b1, b2, b3, b4, b5, b6, b7); SBAR();
  VRD8(3, b0, b1, b2, b3, b4, b5, b6, b7);
  asm volatile("s_waitcnt lgkmcnt(8)" ::: "memory"); SBAR();
  MMA4(o[2], a0, a1, a2, a3, a4, a5, a6, a7); SBAR();
  asm volatile("s_waitcnt lgkmcnt(0)" ::: "memory"); SBAR();
  MMA4(o[3], b0, b1, b2, b3, b4, b5, b6, b7);
}
__device__ __forceinline__ void pv_partial(f32x16* o, int vb, bf16x8 pa0, bf16x8 pa1, bf16x8 pa2, bf16x8 pa3, f32x16& p0, f32x16& p1, float& m_ref, f32x16& negm, float& alpha) {
  s16x4 a0, a1, a2, a3, a4, a5, a6, a7, b0, b1, b2, b3, b4, b5, b6, b7;
  VRD8(0, a0, a1, a2, a3, a4, a5, a6, a7);
  VRD8(1, b0, b1, b2, b3, b4, b5, b6, b7);
  asm volatile("s_waitcnt lgkmcnt(8)" ::: "memory"); SBAR();
  MMA4(o[0], a0, a1, a2, a3, a4, a5, a6, a7);
  float pmax = max3f(p0[0], p0[1], p1[0]), pmb = max3f(p0[2], p0[3], p1[1]);
  pmax = max3f(pmax, p1[2], p1[3]);
#pragma unroll
  for (int r = 4; r < 16; r += 4) { pmax = max3f(pmax, p0[r], p0[r + 1]); pmb = max3f(pmb, p0[r + 2], p0[r + 3]); pmax = max3f(pmax, p1[r], p1[r + 1]); pmb = max3f(pmb, p1[r + 2], p1[r + 3]); }
  pmax = max3f(pmax, pmb, pmb);
  SBAR();
  VRD8(2, a0, a1, a2, a3, a4, a5, a6, a7);
  asm volatile("s_waitcnt lgkmcnt(8)" ::: "memory"); SBAR();
  MMA4(o[1], b0, b1, b2, b3, b4, b5, b6, b7);
  { auto rr = __builtin_amdgcn_permlane32_swap(__float_as_uint(pmax), __float_as_uint(pmax), false, false);
    pmax = fmaxf(__uint_as_float(rr[0]), __uint_as_float(rr[1])); }
  alpha = 1.f;
  if (!__builtin_expect(__all(pmax <= THR), 1)) {
    const float dl = fmaxf(pmax, 0.f); m_ref += dl; alpha = __builtin_amdgcn_exp2f(-dl);
#pragma unroll
    for (int r = 0; r < 16; ++r) { p0[r] -= dl; p1[r] -= dl; negm[r] -= dl; }
  }
  SBAR();
  VRD8(3, b0, b1, b2, b3, b4, b5, b6, b7);
  asm volatile("s_waitcnt lgkmcnt(8)" ::: "memory"); SBAR();
  MMA4(o[2], a0, a1, a2, a3, a4, a5, a6, a7);
#pragma unroll
  for (int r = 0; r < 8; ++r) p0[r] = __builtin_amdgcn_exp2f(p0[r]);
  SBAR();
  asm volatile("s_waitcnt lgkmcnt(0)" ::: "memory"); SBAR();
  MMA4(o[3], b0, b1, b2, b3, b4, b5, b6, b7);
#pragma unroll
  for (int r = 8; r < 16; ++r) p0[r] = __builtin_amdgcn_exp2f(p0[r]);
}
#undef VRD8
#undef PK
#undef MMA4

template <int MODE, int ORD>
__device__ __forceinline__ void attn_unit(const bf16* __restrict__ Qb, const bf16* __restrict__ Kh, const bf16* __restrict__ Vh, bf16* __restrict__ Ob,
                                          int qpos0, int kbeg, int NT, const float* __restrict__ tabsrc, float sinkv, float lam, float oscale,
                                          const float* __restrict__ subg, char* lds) {
  constexpr int ND0 = MODE == 0 ? 4 : 8;
  const float C = (MODE == 0 ? 0.125f : 0.08838834764831845f) * LOG2E;
  int tid_ = threadIdx.x; asm volatile("" : "+v"(tid_));
  const int tid = tid_, wid = __builtin_amdgcn_readfirstlane(tid >> 6), lane = tid & 63; int r32 = lane & 31, hi = lane >> 5;
  const int wq = MODE == 0 ? (wid & 3) : wid, cst = MODE == 0 ? (wid >> 2) : 0;
  char* V_lds = lds + OFF_V; char* K_lds = lds + OFF_K;
  float* wsf = (float*)(lds + OFF_WS) + wid * 64; float* li_l = wsf; float* al_l = wsf + 32;
  float* tab = (float*)(lds + OFF_TAB);
  __syncthreads();
  if (wid >= 4) __builtin_amdgcn_s_setprio(1);
  if (tid < 257) tab[tid] = tabsrc[t5_bucket(tid - 128) * 16] * LOG2E;
  float m_reg = MODE == 0 ? 0.f : sinkv * LOG2E, l_reg = MODE == 0 ? 0.f : 1.f;
  f32x16 o[4] = {}; bf16x8 qr[ND0];
  const bf16* Qw = Qb + (long)(wq * 32 + r32) * LDP + cst * 64 + hi * 8;
#pragma unroll
  for (int d0 = 0; d0 < ND0; ++d0) qr[d0] = scale_bf16x8(ld8(Qw + d0 * 16), C);
  const int qpos = qpos0 + wq * 32 + r32;
  const int qw0 = qpos0 + wq * 32;
  const int cboff = cst * 128;
  int sr = tid >> 4, sc = (tid & 15) * 8, vst0 = v_st(sr, sc), vst1 = v_st(32 + sr, sc);
  int vb0 = (int)(uintptr_t)V_lds + v_rd_base(lane);
  const bf16* Kg = Kh + (long)kbeg * LDP; const bf16* Vg = Vh + (long)kbeg * LDP;
  struct { bf16x8 vs0, vs1, ks0, ks1; } sr_[1];
#define SLOAD(i, k0) do { sr_[i].vs0 = ld8(&Vg[(long)((k0) + sr) * LDP + sc]); sr_[i].vs1 = ld8(&Vg[(long)((k0) + 32 + sr) * LDP + sc]); \
    sr_[i].ks0 = ld8(&Kg[(long)((k0) + sr) * LDP + sc]); sr_[i].ks1 = ld8(&Kg[(long)((k0) + 32 + sr) * LDP + sc]); } while (0)
#define SWRITE(off, i) do { *(bf16x8*)(V_lds + (off) + vst0) = sr_[i].vs0;          \
    *(bf16x8*)(V_lds + (off) + vst1) = sr_[i].vs1; int kc = sc * 2;               \
    *(bf16x8*)(K_lds + (off) + KSWZ(sr, kc)) = sr_[i].ks0;                       \
    *(bf16x8*)(K_lds + (off) + KSWZ(32 + sr, kc)) = sr_[i].ks1; } while (0)
#define SWAIT() asm volatile("s_waitcnt vmcnt(0)" ::: "memory")
#define RESC(a) do { if (__any((a) < 1.f)) { if (hi == 0) al_l[r32] = (a); asm volatile("s_waitcnt lgkmcnt(0)" ::: "memory"); \
    _Pragma("unroll") for (int d = 0; d < 4; ++d) _Pragma("unroll") for (int r = 0; r < 16; ++r) o[d][r] *= al_l[crow(r, hi)]; } } while (0)
  float bL, bR, be_cur = 0.f; f32x16 negm;
#pragma unroll
  for (int r = 0; r < 16; ++r) negm[r] = -m_reg;
#define TCLS(t) const int k0_ = kbeg + (t) * KVBLK; const int rmax_ = k0_ + 63 - qw0, rmin_ = k0_ - qw0 - 31; const bool near_ = (MODE == 1) || (rmax_ > -128 && rmin_ < 128)
#define SETBE(t) do { TCLS(t); const float bt_ = near_ ? 0.f : ((rmax_ <= -128) ? bL : bR); \
    if (bt_ != be_cur) { const float d_ = bt_ - be_cur; _Pragma("unroll") for (int r = 0; r < 16; ++r) negm[r] += d_; be_cur = bt_; } } while (0)
#define BIAS(P0, P1, t) do { TCLS(t); (void)rmin_; (void)rmax_; \
    if (near_) { asm volatile("" ::: "memory");     \
      const int base_ = k0_ - qpos + 128 + 4 * hi; \
      _Pragma("unroll") for (int r = 0; r < 16; ++r) { const int i0 = base_ + (r & 3) + 8 * (r >> 2), i1 = i0 + 32; \
        const int c0 = i0 < 0 ? 0 : (i0 > 256 ? 256 : i0), c1 = i1 < 0 ? 0 : (i1 > 256 ? 256 : i1); \
        const float t0 = P0[r] + tab[c0], t1 = P1[r] + tab[c1]; \
        if (MODE == 1) { P0[r] = (i0 == c0) ? t0 : NEGB; P1[r] = (i1 == c1) ? t1 : NEGB; } else { P0[r] = t0; P1[r] = t1; } } \
      asm volatile("" ::: "memory"); } } while (0)
  f32x16 pA0, pA1, pB0, pB1; float alA, alB; bf16x8 pa0, pa1, pa2, pa3;
  constexpr int SE = 0, SO = 0;
  SLOAD(SE, 0); asm volatile("s_waitcnt vmcnt(0)" ::: "memory"); SWRITE(0, SE); __syncthreads();
  bL = tab[0]; bR = tab[256];
  SETBE(0); qkt<ND0>(pA0, pA1, K_lds, qr, r32, hi, cboff, negm); BIAS(pA0, pA1, 0); partialSM2<MODE == 0>(pA0, pA1, m_reg, negm, alA);
  SLOAD(SO, KVBLK);
  SWAIT(); SWRITE(SLOT, SO); __syncthreads();
  int op = 0, oc = SLOT, on = 2 * SLOT;
#define ROT() do { const int t_ = op; op = oc; oc = on; on = t_; } while (0)
#define TILE_STEP1(PN0, PN1, ALN, PO0, PO1, ALO, TN, LOADS) do { \
      SBAR(); finishSM(PO0, PO1, ALO, l_reg, pa0, pa1, pa2, pa3); SBAR(); LOADS; SETBE(TN); SBAR(); qkt<ND0>(PN0, PN1, K_lds + oc, qr, r32, hi, cboff, negm); SBAR(); \
      BIAS(PN0, PN1, TN); partialSM2<false>(PN0, PN1, m_reg, negm, ALN); SBAR(); pv_d0(o, vb0 + op, pa0, pa1, pa2, pa3); } while (0)
#define MAIN_LOOP(TS) do { \
  for (int j = 1; j + 1 < NT; j += 2) { \
    TS(pB0, pB1, alB, pA0, pA1, alA, j, SLOAD(SO, (j + 1) * KVBLK)); \
    SWAIT(); SWRITE(on, SE); RESC(alB); __syncthreads(); ROT(); \
    TS(pA0, pA1, alA, pB0, pB1, alB, j + 1, SLOAD(SE, (j + 2) * KVBLK)); \
    SWAIT(); SWRITE(on, SO); RESC(alA); __syncthreads(); ROT(); \
  } \
  TS(pB0, pB1, alB, pA0, pA1, alA, NT - 1, (void)0); } while (0)
#define TILE_STEPX(PN0, PN1, ALN, PO0, PO1, ALO, TN, LOADS) do { \
      SBAR(); LOADS; SETBE(TN); SBAR(); qkt<ND0>(PN0, PN1, K_lds + oc, qr, r32, hi, cboff, negm); finishSM(PO0, PO1, ALO, l_reg, pa0, pa1, pa2, pa3); SBAR(); \
      BIAS(PN0, PN1, TN); SBAR(); pv_partial(o, vb0 + op, pa0, pa1, pa2, pa3, PN0, PN1, m_reg, negm, ALN); } while (0)
  MAIN_LOOP(TILE_STEPX);
#undef MAIN_LOOP
#undef TILE_STEPX
#undef TILE_STEP1
#undef SETBE
#undef TCLS
  RESC(alB);
  finishSM(pB0, pB1, alB, l_reg, pa0, pa1, pa2, pa3); SBAR();
  pv_d0(o, vb0 + oc, pa0, pa1, pa2, pa3);
#undef ROT
  if (hi == 0) li_l[r32] = l_reg; asm volatile("s_waitcnt lgkmcnt(0)" ::: "memory");
  float rli[16];
#pragma unroll
  for (int r = 0; r < 16; ++r) rli[r] = __builtin_amdgcn_rcpf(li_l[crow(r, hi)]);
  if (MODE == 1) {
    bf16* Ow = Ob + (long)(wq * 32) * LDO;
#pragma unroll
    for (int r = 0; r < 16; ++r) { const int orow = crow(r, hi);
#pragma unroll
      for (int d0 = 0; d0 < 4; ++d0) { __hip_bfloat16 bv = __float2bfloat16(o[d0][r] * rli[r]); Ow[(long)orow * LDO + d0 * 32 + r32] = *reinterpret_cast<bf16*>(&bv); } }
  } else {
    __syncthreads();
    float* X = (float*)lds + wq * 4096;
    if (cst == 1) {
#pragma unroll
      for (int r = 0; r < 16; ++r) { const int orow = crow(r, hi);
#pragma unroll
        for (int d0 = 0; d0 < 4; ++d0) X[orow * 128 + d0 * 32 + r32] = o[d0][r] * rli[r]; }
    }
    __syncthreads();
    if (cst == 0) {
      float ssq[16];
#pragma unroll
      for (int r = 0; r < 16; ++r) { const int orow = crow(r, hi); float s = 0.f;
#pragma unroll
        for (int d0 = 0; d0 < 4; ++d0) { const float v = o[d0][r] * rli[r] - lam * X[orow * 128 + d0 * 32 + r32]; o[d0][r] = v; s = fmaf(v, v, s); }
        ssq[r] = s; }
#pragma unroll
      for (int r = 0; r < 16; ++r) {
#pragma unroll
        for (int off = 1; off < 32; off <<= 1) ssq[r] += __shfl_xor(ssq[r], off);
      }
      float gg[4];
#pragma unroll
      for (int d0 = 0; d0 < 4; ++d0) gg[d0] = subg[d0 * 32 + r32] * oscale;
      bf16* Ow = Ob + (long)(wq * 32) * LDO;
#pragma unroll
      for (int r = 0; r < 16; ++r) { const int orow = crow(r, hi); const float rs = __builtin_amdgcn_rsqf(ssq[r] * (1.f / 128.f) + 1e-6f);
#pragma unroll
        for (int d0 = 0; d0 < 4; ++d0) { __hip_bfloat16 bv = __float2bfloat16(o[d0][r] * rs * gg[d0]); Ow[(long)orow * LDO + d0 * 32 + r32] = *reinterpret_cast<bf16*>(&bv); } }
    }
  }
  __builtin_amdgcn_s_setprio(0);
#undef SLOAD
#undef SWRITE
#undef SWAIT
#undef RESC
#undef BIAS
}
#undef SBAR
}

#define LAS __attribute__((address_space(3)))
typedef unsigned short bf16;
typedef unsigned v4u __attribute__((ext_vector_type(4)));
typedef float f32x4 __attribute__((ext_vector_type(4)));
constexpr int NWAVES = 8;
constexpr int DM = 2048, SEQ_P = 8192, NB_P = 4, SEQ_S = 4096, NB_S = 2, DEPTH = 2, DFF = 8192, INW = 4608;
constexpr int M_P = NB_P * SEQ_P, M_S = NB_S * SEQ_S, M = M_P + M_S;
constexpr size_t MiB = 1u << 20;
constexpr size_t WS_WIN = 1 * MiB;
constexpr size_t WS_WOUT = WS_WIN + (size_t)DEPTH * INW * DM * 2;
constexpr size_t WS_WF1 = WS_WOUT + (size_t)DEPTH * DM * DM * 2;
constexpr size_t WS_WF2 = WS_WF1 + (size_t)DEPTH * DFF * DM * 2;
constexpr size_t WS_XN = WS_WF2 + (size_t)DEPTH * DM * DFF * 2;
constexpr size_t WS_H = WS_XN + (size_t)M * DM * 2;
constexpr size_t WS_PROJ = WS_H;
constexpr size_t WS_ATT = WS_PROJ + (size_t)M * INW * 2;
constexpr size_t WS_END = WS_H + (size_t)M * DFF * 2;
static_assert(WS_ATT + (size_t)M * DM * 2 <= WS_END, "overlay");
constexpr int LDS_BYTES = 147456;
static_assert(att::ATT_LDS <= 131072, "attention LDS");

__device__ __forceinline__ unsigned f2bf(float f) { unsigned u = __builtin_bit_cast(unsigned, f); return (u + 0x7fffu + ((u >> 16) & 1u)) >> 16; }
__device__ __forceinline__ unsigned pk2(float lo, float hi) { return f2bf(lo) | (f2bf(hi) << 16); }
__device__ __forceinline__ float wave_sum(float v) {
#pragma unroll
    for (int o = 1; o < 64; o <<= 1) v += __shfl_xor(v, o);
    return v;
}
__device__ __forceinline__ void transpose_item(const float* W, int K, int N, bf16* WT, LAS float* scr, int item, int lane) {
    const int nblk = N / 32, kb = item / nblk, nb = item % nblk, k0 = 64 * kb, n0 = 32 * nb;
#pragma unroll 16
    for (int i = 0; i < 32; ++i) { const int kk = 2 * i + (lane >> 5); scr[kk * 33 + (lane & 31)] = W[(size_t)(k0 + kk) * N + n0 + (lane & 31)]; }
    asm volatile("s_waitcnt lgkmcnt(0)" ::: "memory");
    const int c = lane & 7;
#pragma unroll
    for (int j = 0; j < 4; ++j) { const int n = (lane >> 3) + 8 * j; const LAS float* s = scr + (8 * c) * 33 + n;
        v4u o; o.x = pk2(s[0 * 33], s[1 * 33]); o.y = pk2(s[2 * 33], s[3 * 33]); o.z = pk2(s[4 * 33], s[5 * 33]); o.w = pk2(s[6 * 33], s[7 * 33]);
        *(v4u*)(WT + (size_t)(n0 + n) * K + k0 + 8 * c) = o; }
    asm volatile("s_waitcnt lgkmcnt(0)" ::: "memory");
}
__device__ __forceinline__ float xg_row_bf16(const float* xrow, const float* g, bf16* orow, int lane) {
    const f32x4* xr = (const f32x4*)xrow + lane; const f32x4* gr = (const f32x4*)g + lane;
    f32x4 v[8]; float s = 0.f;
#pragma unroll
    for (int j = 0; j < 8; ++j) { v[j] = xr[64 * j]; s += (v[j].x * v[j].x + v[j].y * v[j].y) + (v[j].z * v[j].z + v[j].w * v[j].w); }
    unsigned long long* o8 = (unsigned long long*)orow + lane;
#pragma unroll
    for (int j = 0; j < 8; ++j) { const f32x4 gg = gr[64 * j]; o8[64 * j] = (unsigned long long)pk2(v[j].x * gg.x, v[j].y * gg.y) | ((unsigned long long)pk2(v[j].z * gg.z, v[j].w * gg.w) << 32); }
    return wave_sum(s);
}
struct Args { const float* in[16]; float* out; unsigned char* ws; int ph_lo, ph_hi; };
constexpr int N_PHASES = 2 + 5 * DEPTH;
constexpr size_t WS_SSQ = 0;

__global__ void __launch_bounds__(NWAVES * 64, 2) mega_fwd(Args args) {
    extern __shared__ __attribute__((aligned(16))) unsigned char lds[];
    cg::grid_group grid = cg::this_grid();
    const int tid = threadIdx.x, wave = __builtin_amdgcn_readfirstlane(tid >> 6); int lane = tid & 63;
#define LAUNDER() asm volatile("" : "+v"(lane))
    const int G = gridDim.x, bx = blockIdx.x;
    const int vcu = (G % 8 == 0) ? (bx % 8) * (G / 8) + bx / 8 : bx;
    const int gw = vcu * NWAVES + wave, NGW = G * NWAVES;
    unsigned char* ws = args.ws;
    const float* x_prompt = args.in[0]; const float* x_sample = args.in[1]; const float* rel_bias = args.in[2];
    const float* norm1_g = args.in[3]; const float* w_in = args.in[4];
    const float* lq1 = args.in[5]; const float* lk1 = args.in[6]; const float* lq2 = args.in[7]; const float* lk2 = args.in[8];
    const float* subln_g = args.in[9]; const float* sink = args.in[10]; const float* w_out = args.in[11]; const float* norm2_g = args.in[12];
    const float* w_f1 = args.in[13]; const float* w_f2 = args.in[14]; const float* fin_g = args.in[15];
    float* out = args.out;
    bf16* Win_t = (bf16*)(ws + WS_WIN); bf16* Wout_t = (bf16*)(ws + WS_WOUT); bf16* Wf1_t = (bf16*)(ws + WS_WF1); bf16* Wf2_t = (bf16*)(ws + WS_WF2);
    float* SSQ = (float*)(ws + WS_SSQ);
    bf16* XN = (bf16*)(ws + WS_XN); bf16* HB = (bf16*)(ws + WS_H); bf16* PROJ = (bf16*)(ws + WS_PROJ); bf16* ATT = (bf16*)(ws + WS_ATT);
    const int lo = args.ph_lo, hi = args.ph_hi;
#define IN(k) (lo <= (k) && (k) < hi)
#define SEAM(k) do { if (IN(k) && IN((k) + 1)) grid.sync(); } while (0)

    if (IN(0)) {
        LAUNDER();
        LAS float* scr = (LAS float*)((LAS unsigned char*)lds + wave * 16384);
        constexpr int I_IN = (DM / 64) * (INW / 32), I_OUT = (DM / 64) * (DM / 32), I_F1 = (DM / 64) * (DFF / 32), I_F2 = (DFF / 64) * (DM / 32);
        constexpr int I_L = I_IN + I_OUT + I_F1 + I_F2;
        for (int it = gw; it < DEPTH * I_L; it += NGW) {
            const int l = it / I_L; int r = it % I_L;
            if (r < I_IN) { transpose_item(w_in + (size_t)l * DM * INW, DM, INW, Win_t + (size_t)l * INW * DM, scr, r, lane); continue; } r -= I_IN;
            if (r < I_OUT) { transpose_item(w_out + (size_t)l * DM * DM, DM, DM, Wout_t + (size_t)l * DM * DM, scr, r, lane); continue; } r -= I_OUT;
            if (r < I_F1) { transpose_item(w_f1 + (size_t)l * DM * DFF, DM, DFF, Wf1_t + (size_t)l * DFF * DM, scr, r, lane); continue; } r -= I_F1;
            transpose_item(w_f2 + (size_t)l * DFF * DM, DFF, DM, Wf2_t + (size_t)l * DM * DFF, scr, r, lane);
        }
        for (int i = (vcu * NWAVES * 64 + tid); i < 4 * M; i += G * NWAVES * 64) SSQ[M + i] = 0.f;
        for (int m = gw; m < M; m += NGW) { const float* xr = m < M_P ? x_prompt + (size_t)m * DM : x_sample + (size_t)(m - M_P) * DM; const float sq = xg_row_bf16(xr, norm1_g, XN + (size_t)m * DM, lane); if (lane == 0) SSQ[m] = sq; }
    }
    SEAM(0);
#pragma unroll
    for (int l = 0; l < DEPTH; ++l) {
        const int pb = 1 + 5 * l;
        if (IN(pb)) {
            pg8::Gemm g{XN, Win_t + (size_t)l * INW * DM, M, INW, DM}; pg8::StaticOrder S; S.init(M, INW, G, bx);
            pg8::EpiBf16<0> E{PROJ, INW, SSQ + (size_t)(2 * l) * M};
            pg8::gemm_phase<pg8::EpiBf16<0>, pg8::StaticOrder, true, true>((LAS unsigned char*)lds, g, S, E);
        }
        SEAM(pb);
        if (IN(pb + 1)) {
            LAUNDER();
            const float lambda_init = 0.8f - 0.6f * expf(-0.3f * (float)l);
            float d1 = lq1[l * 64 + lane] * lk1[l * 64 + lane], d2 = lq2[l * 64 + lane] * lk2[l * 64 + lane];
            d1 = wave_sum(d1); d2 = wave_sum(d2);
            const float lam = expf(d1) - expf(d2) + lambda_init;
#pragma unroll 1
            for (int U = vcu; U < 2560; U += G) {
                int pair, qb, S; size_t row0;
                if (U < 2048) { const int r = U >> 8, v = U & 255, x = v >> 5, cu = v & 31; pair = x * 4 + (r >> 1); qb = (r & 1) * 32 + cu; S = SEQ_P; row0 = (size_t)(pair >> 3) * SEQ_P; }
                else { const int U2 = U - 2048; const int r = U2 >> 8, v = U2 & 255, x = v >> 5, cu = v & 31; pair = x * 2 + r; qb = cu; S = SEQ_S; row0 = (size_t)M_P + (size_t)(pair >> 3) * SEQ_S; }
                const int h = pair & 7;
                if (false) att::attn_unit<0, 0>(PROJ + (row0 + qb * 128) * INW + h * 128, PROJ + row0 * INW + 1024 + h * 128, PROJ + row0 * INW + 2048 + h * 128,
                                  ATT + (row0 + qb * 128) * DM + h * 128, qb * 128, 0, S / 64, rel_bias + h, 0.f, lam, 1.f - lambda_init, subln_g + l * 128, (char*)lds);
                else att::attn_unit<0, 1>(PROJ + (row0 + qb * 128) * INW + h * 128, PROJ + row0 * INW + 1024 + h * 128, PROJ + row0 * INW + 2048 + h * 128,
                                  ATT + (row0 + qb * 128) * DM + h * 128, qb * 128, 0, S / 64, rel_bias + h, 0.f, lam, 1.f - lambda_init, subln_g + l * 128, (char*)lds);
            }
#pragma unroll 1
            for (int U3 = vcu; U3 < 1280; U3 += G) {
                const int r = U3 >> 8, v = U3 & 255; const int w = v * 5 + r; const int rbk = w >> 3, hq = w & 7, kvh = hq >> 2;
                const size_t grow = (size_t)rbk * 256;
                const bool isP = grow < (size_t)M_P; const int S = isP ? SEQ_P : SEQ_S;
                const size_t row0 = isP ? (grow / SEQ_P) * SEQ_P : (size_t)M_P + ((grow - M_P) / SEQ_S) * SEQ_S;
                const int q0 = (int)(grow - row0);
                const int kb = q0 - 128 < 0 ? 0 : q0 - 128, ke = q0 + 384 > S ? S : q0 + 384;
                if (false) att::attn_unit<1, 0>(PROJ + grow * INW + 3072 + hq * 128, PROJ + row0 * INW + 4096 + kvh * 128, PROJ + row0 * INW + 4352 + kvh * 128,
                                  ATT + grow * DM + 1024 + hq * 128, q0, kb, (ke - kb) / 64, rel_bias + 8 + hq, sink[l * 8 + hq], 0.f, 1.f, nullptr, (char*)lds);
                else att::attn_unit<1, 1>(PROJ + grow * INW + 3072 + hq * 128, PROJ + row0 * INW + 4096 + kvh * 128, PROJ + row0 * INW + 4352 + kvh * 128,
                                  ATT + grow * DM + 1024 + hq * 128, q0, kb, (ke - kb) / 64, rel_bias + 8 + hq, sink[l * 8 + hq], 0.f, 1.f, nullptr, (char*)lds);
            }
            __syncthreads();
        }
        SEAM(pb + 1);
        if (IN(pb + 2)) {
            pg8::Gemm g{ATT, Wout_t + (size_t)l * DM * DM, M, DM, DM}; pg8::StaticOrder S; S.init(M, DM, G, bx);
            pg8::EpiResF32 E{l == 0 ? x_prompt : out, l == 0 ? x_sample : out + (size_t)M_P * DM, M_P, out, XN, norm2_g + l * DM, SSQ + (size_t)(2 * l + 1) * M};
            pg8::gemm_phase<pg8::EpiResF32, pg8::StaticOrder, true, true>((LAS unsigned char*)lds, g, S, E);
        }
        SEAM(pb + 2);
        if (IN(pb + 3)) {
            pg8::Gemm g{XN, Wf1_t + (size_t)l * DFF * DM, M, DFF, DM}; pg8::StaticOrder S; S.init(M, DFF, G, bx);
            pg8::EpiBf16<1> E{HB, DFF, SSQ + (size_t)(2 * l + 1) * M};
            pg8::gemm_phase<pg8::EpiBf16<1>, pg8::StaticOrder, true, true>((LAS unsigned char*)lds, g, S, E);
        }
        SEAM(pb + 3);
        if (IN(pb + 4)) {
            pg8::Gemm g{HB, Wf2_t + (size_t)l * DM * DFF, M, DM, DFF}; pg8::StaticOrder S; S.init(M, DM, G, bx);
            pg8::EpiResF32 E{out, out + (size_t)M_P * DM, M_P, out, l + 1 < DEPTH ? XN : nullptr, l + 1 < DEPTH ? norm1_g + (l + 1) * DM : fin_g, SSQ + (size_t)(2 * l + 2) * M};
            pg8::gemm_phase<pg8::EpiResF32, pg8::StaticOrder, true, true>((LAS unsigned char*)lds, g, S, E);
        }
        SEAM(pb + 4);
    }
    if (IN(1 + 5 * DEPTH)) {
        LAUNDER();
        const float* sq = SSQ + (size_t)(2 * DEPTH) * M;
        for (int m = gw; m < M; m += NGW) { f32x4* xr = (f32x4*)(out + (size_t)m * DM) + lane; const f32x4* gr = (const f32x4*)fin_g + lane; const float rs = 1.f / sqrtf(sq[m] * (1.f / DM) + 1e-6f);
#pragma unroll
            for (int j = 0; j < 8; ++j) xr[64 * j] = xr[64 * j] * rs * gr[64 * j]; }
    }
#undef IN
#undef SEAM
}

extern "C" void kernel_launch(void* const* d_in, const int* in_sizes, int n_in, void* d_out, int out_size, void* d_ws, size_t ws_size, hipStream_t stream) {
    static int grid = 0;
    if (grid == 0) {
        if (n_in != 16 || in_sizes[0] != M_P * DM || in_sizes[1] != M_S * DM || out_size != M * DM || ws_size < WS_END) {
            fprintf(stderr, "kernel_launch: shape/workspace mismatch: n_in %d in0 %d in1 %d out %d ws %zu (need %zu)\n", n_in, n_in > 0 ? in_sizes[0] : -1, n_in > 1 ? in_sizes[1] : -1, out_size, ws_size, (size_t)WS_END);
            grid = -1; return; }
        int dev = 0, cus = 0, per_cu = 0;
        hipGetDevice(&dev); hipDeviceGetAttribute(&cus, hipDeviceAttributeMultiprocessorCount, dev);
        if (hipFuncSetAttribute((const void*)mega_fwd, hipFuncAttributeMaxDynamicSharedMemorySize, LDS_BYTES) != hipSuccess) { fprintf(stderr, "kernel_launch: hipFuncSetAttribute failed\n"); grid = -1; return; }
        if (hipOccupancyMaxActiveBlocksPerMultiprocessor(&per_cu, (const void*)mega_fwd, NWAVES * 64, LDS_BYTES) != hipSuccess || per_cu < 1) { fprintf(stderr, "kernel_launch: occupancy query gave %d\n", per_cu); per_cu = 1; }
        (void)hipGetLastError();
        grid = cus * per_cu;
    }
    if (grid < 0) return;
    Args a{};
    for (int i = 0; i < 16; ++i) a.in[i] = (const float*)d_in[i];
    a.out = (float*)d_out; a.ws = (unsigned char*)d_ws;
#if MK_MULTI
    for (int p = 0; p < N_PHASES; ++p) { a.ph_lo = p; a.ph_hi = p + 1; void* kargs[] = {&a};
        hipError_t e = hipLaunchCooperativeKernel((const void*)mega_fwd, dim3(grid), dim3(NWAVES * 64), kargs, LDS_BYTES, stream);
        if (e != hipSuccess) { fprintf(stderr, "kernel_launch: launch %d failed: %s (grid %d)\n", p, hipGetErrorString(e), grid); break; } }
#else
    a.ph_lo = 0; a.ph_hi = N_PHASES; void* kargs[] = {&a};
    hipError_t e = hipLaunchCooperativeKernel((const void*)mega_fwd, dim3(grid), dim3(NWAVES * 64), kargs, LDS_BYTES, stream);
    if (e != hipSuccess) fprintf(stderr, "kernel_launch: cooperative launch failed: %s (grid %d)\n", hipGetErrorString(e), grid);
#endif
}
```

```cpp
#include <hip/hip_runtime.h>
#include <hip/hip_bf16.h>
#include <hip/hip_cooperative_groups.h>
#include <cstdio>
#include <cstdint>
namespace cg = cooperative_groups;

#ifndef MK_MULTI
#define MK_MULTI 0
#endif


namespace pg8 {
#define PG8_LAS __attribute__((address_space(3)))
typedef unsigned short bf16_t;
typedef short bf16x8 __attribute__((ext_vector_type(8)));
typedef float f32x4 __attribute__((ext_vector_type(4)));
typedef unsigned u32x4 __attribute__((ext_vector_type(4)));
constexpr int BM = 256, BK = 64, HALF = 128, HTB = HALF * BK * 2  , STAGE_BYTES = 8 * HTB, NXCD = 8, WGM = 8;

__host__ __device__ __forceinline__ int lds_byte(int r, int c) { const int st = (r >> 4) * 2 + (c >> 5), rr = r & 15, cc = c & 31, ob = rr * 64 + cc * 2; return st * 1024 + (ob ^ (((ob >> 9) & 1) << 5)); }
__host__ __device__ __forceinline__ void stage_rc(int b, int& R, int& C) { const int st = b / 1024, sb = b % 1024, swz = sb ^ (((sb >> 9) & 1) << 5); R = (st >> 1) * 16 + swz / 64; C = (st & 1) * 32 + (swz % 64) / 2; }
__host__ __device__ __forceinline__ int perm32(int rho) { const int n = rho >> 4, i = rho & 15; return 8 * (i >> 2) + 4 * n + (i & 3); }

struct Unit { int pm, pn; };
struct Gemm { const bf16_t* A; const bf16_t* Bt; int M, N, K; };

struct StaticOrder {
    int nM, nN, nwg, G, c;
    __host__ __device__ void init(int M, int N, int G_, int c_) { nM = M / BM; nN = N / BM; nwg = nM * nN; G = G_; c = c_; }
    __host__ __device__ bool next(int i, Unit& u) const {
        const long L = (long)i * G + c; if (L >= nwg) return false;
        int wgid = (int)L; { const int q = nwg / NXCD, r = nwg % NXCD, xcd = wgid % NXCD, off = wgid / NXCD; wgid = (xcd < r ? xcd * (q + 1) : r * (q + 1) + (xcd - r) * q) + off; }
        const int nig = WGM * nN, gid = wgid / nig, fm = gid * WGM, gsz = (nM - fm) < WGM ? (nM - fm) : WGM;
        u.pm = fm + ((wgid % nig) % gsz); u.pn = (wgid % nig) / gsz; return true;
    }
    __device__ __forceinline__ void a_ready(const Unit&) const {}
    __device__ __forceinline__ void done(const Unit&) const {}
};

typedef unsigned u32x4 __attribute__((ext_vector_type(4)));
__device__ __forceinline__ unsigned cvt_pk_bf16(float lo, float hi) { unsigned r; asm volatile("v_cvt_pk_bf16_f32 %0, %1, %2" : "=v"(r) : "v"(lo), "v"(hi)); return r; }

template <int ACT  > struct EpiBf16 {
    static constexpr bool PERM = true, AFTER_DRAIN = false;
    bf16_t* O; int ldc; const float* ssq;
    __device__ __forceinline__ void operator()(const f32x4 (&acc)[2][2][4][2], const Unit& u, int wr, int wc, int fr, int fq) const {
        asm volatile("" : "+v"(fr), "+v"(fq));
        const int row0 = u.pm * BM + wr * 64 + fr; const int col0 = u.pn * BM + wc * 32 + 8 * fq;
#pragma unroll
        for (int ai = 0; ai < 2; ++ai)
#pragma unroll
            for (int m = 0; m < 4; ++m) { const int row = row0 + ai * HALF + m * 16; bf16_t* rowp = O + (size_t)row * ldc + col0;
                const float rs = ssq ? __builtin_amdgcn_rsqf(ssq[row] * (1.f / 2048.f) + 1e-6f) : 1.f;
#pragma unroll
                for (int bj = 0; bj < 2; ++bj) { f32x4 v0 = acc[ai][bj][m][0] * rs, v1 = acc[ai][bj][m][1] * rs;
                    if (ACT == 1) {
#pragma unroll
                        for (int e = 0; e < 4; ++e) { float a = fmaxf(v0[e], 0.f), b = fmaxf(v1[e], 0.f); v0[e] = a * a; v1[e] = b * b; } }
                    u32x4 w; w.x = cvt_pk_bf16(v0[0], v0[1]); w.y = cvt_pk_bf16(v0[2], v0[3]); w.z = cvt_pk_bf16(v1[0], v1[1]); w.w = cvt_pk_bf16(v1[2], v1[3]);
                    __builtin_nontemporal_store(w, (u32x4*)(rowp + bj * HALF)); } }
    }
};
struct EpiResF32 {
    static constexpr bool PERM = true, AFTER_DRAIN = false;
    const float* b0; const float* b1; int split; float* out; bf16_t* xn; const float* g; float* ssq; const float* rs2;
    __device__ __forceinline__ void operator()(const f32x4 (&acc)[2][2][4][2], const Unit& u, int wr, int wc, int fr, int fq) const {
        asm volatile("" : "+v"(fr), "+v"(fq));
        const int col0 = u.pn * BM + wc * 32 + 8 * fq;
        const int rt = u.pm * BM; const float* bb = (rt < split) ? b0 + (size_t)rt * 2048 : b1 + (size_t)(rt - split) * 2048; float* oo = out + (size_t)rt * 2048; bf16_t* xx = xn + (size_t)rt * 2048;
        float sacc[2][4];
        f32x4 gv[2][2];
#pragma unroll
        for (int bj = 0; bj < 2; ++bj) { gv[bj][0] = *(const f32x4*)(g + col0 + bj * HALF); gv[bj][1] = *(const f32x4*)(g + col0 + bj * HALF + 4); }
#pragma unroll
        for (int ai = 0; ai < 2; ++ai) {
            f32x4 pre[4][2][2]; float rq[4];
#pragma unroll
            for (int m = 0; m < 4; ++m) { const size_t off = (size_t)(ai * HALF + wr * 64 + m * 16 + fr) * 2048 + col0; rq[m] = rs2 ? rs2[rt + ai * HALF + wr * 64 + m * 16 + fr] : 0.f;
#pragma unroll
                for (int bj = 0; bj < 2; ++bj) { pre[m][bj][0] = *(const f32x4*)(bb + off + bj * HALF); pre[m][bj][1] = *(const f32x4*)(bb + off + bj * HALF + 4); } }
            asm volatile("" ::: "memory");
#pragma unroll
            for (int m = 0; m < 4; ++m) { const int rl = ai * HALF + wr * 64 + m * 16 + fr; const size_t off = (size_t)rl * 2048 + col0; float s = 0.f; const float sc = rs2 ? __builtin_amdgcn_rcpf(rq[m] * (1.f / 2048.f) + 1e-6f) : 1.f;
#pragma unroll
                for (int bj = 0; bj < 2; ++bj) {
                    const f32x4 v0 = pre[m][bj][0] + acc[ai][bj][m][0] * sc, v1 = pre[m][bj][1] + acc[ai][bj][m][1] * sc;
                    *(f32x4*)(oo + off + bj * HALF) = v0; *(f32x4*)(oo + off + bj * HALF + 4) = v1;
                    s += (v0[0] * v0[0] + v0[1] * v0[1]) + (v0[2] * v0[2] + v0[3] * v0[3]) + (v1[0] * v1[0] + v1[1] * v1[1]) + (v1[2] * v1[2] + v1[3] * v1[3]);
                    const f32x4 a = v0 * gv[bj][0], b = v1 * gv[bj][1];
                    u32x4 w; w.x = cvt_pk_bf16(a[0], a[1]); w.y = cvt_pk_bf16(a[2], a[3]); w.z = cvt_pk_bf16(b[0], b[1]); w.w = cvt_pk_bf16(b[2], b[3]);
                    if (xn) *(u32x4*)(xx + off + bj * HALF) = w; }
                s += __shfl_xor(s, 16); s += __shfl_xor(s, 32); sacc[ai][m] = s; }
            asm volatile("" ::: "memory");
        }
        if (fq == 0) {
#pragma unroll
            for (int ai = 0; ai < 2; ++ai)
#pragma unroll
                for (int m = 0; m < 4; ++m) atomicAdd(ssq + rt + ai * HALF + wr * 64 + m * 16 + fr, sacc[ai][m]); }
    }
};
template <class Epi, class Sched, bool ALIGN_EPI = false, bool SP2 = false>
__device__ __forceinline__ void gemm_phase(PG8_LAS unsigned char* lds, const Gemm g, const Sched& S, const Epi& E) {
    int tid_ = threadIdx.x; asm volatile("" : "+v"(tid_));
    const int tid = tid_, wid = __builtin_amdgcn_readfirstlane(tid >> 6), lane = tid & 63, wr = wid >> 2, wc = wid & 3, fr = lane & 15, fq = lane >> 4;
    const int K = g.K, nt = K / BK;
    unsigned voffA[2], voffB[2];
#pragma unroll
    for (int i = 0; i < 2; ++i) { int R, C; stage_rc(tid * 16 + i * 8192, R, C); const int Rb = Epi::PERM ? ((R & ~31) + perm32(R & 31)) : R;
        voffA[i] = (unsigned)(R * K + C) * 2u; voffB[i] = (unsigned)(Rb * K + C) * 2u; }
    const size_t kstep = (size_t)(BK * 2);
    const size_t hstep = (size_t)HALF * K * 2;
    const size_t tstep = 2 * hstep;
    const unsigned ldsw = (unsigned)wid * 1024u;
    const int aoff = lds_byte(wr * 64 + fr, fq * 8), boff = lds_byte(wc * 32 + fr, fq * 8);
#define PG8_SA(b, h) (((b) * 2 + (h)) * HTB)
#define PG8_SB(b, h) ((4 + (b) * 2 + (h)) * HTB)
#define PG8_STAGE(bufoff, gbase, voff) do { _Pragma("unroll") for (int _i = 0; _i < 2; ++_i) \
        __builtin_amdgcn_global_load_lds((const unsigned*)((const char*)(gbase) + (voff)[_i]), (PG8_LAS unsigned*)(lds + (bufoff) + ldsw + _i * 8192), 16, 0, 0); } while (0)
#define PG8_LDA(dst, b, h) do { _Pragma("unroll") for (int m = 0; m < 4; ++m) _Pragma("unroll") for (int k = 0; k < 2; ++k) dst[m][k] = *(const PG8_LAS bf16x8*)(lds + PG8_SA(b, h) + aoff + m * 2048 + k * 1024); } while (0)
#define PG8_LDB(dst, b, h) do { _Pragma("unroll") for (int n = 0; n < 2; ++n) _Pragma("unroll") for (int k = 0; k < 2; ++k) dst[n][k] = *(const PG8_LAS bf16x8*)(lds + PG8_SB(b, h) + boff + n * 2048 + k * 1024); } while (0)
#define PG8_MMA(ai, bj, At, Bt) do { __builtin_amdgcn_s_setprio(1); _Pragma("unroll") for (int m = 0; m < 4; ++m) _Pragma("unroll") for (int n = 0; n < 2; ++n) _Pragma("unroll") for (int k = 0; k < 2; ++k) \
        acc[ai][bj][m][n] = __builtin_amdgcn_mfma_f32_16x16x32_bf16(Bt[n][k], At[m][k], acc[ai][bj][m][n], 0, 0, 0); __builtin_amdgcn_s_setprio(0); } while (0)
#define PG8_WAIT_V(n) asm volatile("s_waitcnt vmcnt(" #n ")" ::: "memory")
#define PG8_WAIT_L(n) asm volatile("s_waitcnt lgkmcnt(" #n ")" ::: "memory")
#define PG8_BAR __builtin_amdgcn_s_barrier()
#define PG8_SCHED __builtin_amdgcn_sched_barrier(0)
    Unit cur, nxt; int ui = 0;
    if (!S.next(0, cur)) return;
    f32x4 acc[2][2][4][2];
#pragma unroll
    for (int a = 0; a < 2; ++a)
#pragma unroll
        for (int b = 0; b < 2; ++b)
#pragma unroll
            for (int m = 0; m < 4; ++m)
#pragma unroll
                for (int n = 0; n < 2; ++n) acc[a][b][m][n] = (f32x4){0.f, 0.f, 0.f, 0.f};
    bf16x8 At[4][2], B0[2][2], B1[2][2];
    const char* cA = (const char*)g.A + (size_t)cur.pm * tstep; const char* cB = (const char*)g.Bt + (size_t)cur.pn * tstep;
    S.a_ready(cur);
    if constexpr (SP2) {
        PG8_STAGE(PG8_SB(0, 0), cB, voffB); PG8_STAGE(PG8_SB(0, 1), cB + hstep, voffB); PG8_STAGE(PG8_SA(0, 0), cA, voffA); PG8_STAGE(PG8_SA(0, 1), cA + hstep, voffA);
        if (wr == 1) PG8_BAR;
        PG8_WAIT_V(2); PG8_BAR;
        PG8_STAGE(PG8_SB(1, 0), cB + kstep, voffB); PG8_STAGE(PG8_SA(1, 0), cA + kstep, voffA); PG8_STAGE(PG8_SB(1, 1), cB + hstep + kstep, voffB);
        PG8_WAIT_V(6); PG8_BAR;
    } else {
        PG8_STAGE(PG8_SB(0, 0), cB, voffB); PG8_STAGE(PG8_SA(0, 0), cA, voffA); PG8_STAGE(PG8_SB(0, 1), cB + hstep, voffB); PG8_STAGE(PG8_SA(0, 1), cA + hstep, voffA);
        if (wr == 1) PG8_BAR;
        PG8_WAIT_V(4); PG8_BAR;
        PG8_STAGE(PG8_SB(1, 0), cB + kstep, voffB); PG8_STAGE(PG8_SA(1, 0), cA + kstep, voffA); PG8_STAGE(PG8_SB(1, 1), cB + hstep + kstep, voffB);
        PG8_WAIT_V(6); PG8_BAR;
    }
    for (;;) {
        const bool has_next = S.next(ui + 1, nxt);
        const char* nA = has_next ? (const char*)g.A + (size_t)nxt.pm * tstep : cA; const char* nB = has_next ? (const char*)g.Bt + (size_t)nxt.pn * tstep : cB;
        for (int t = 0; t < nt; t += 2) {
            const bool last = (t == nt - 2);
            const char* a1 = cA + (size_t)(t + 1) * kstep;
            const char* a2 = last ? nA : cA + (size_t)(t + 2) * kstep; const char* b2 = last ? nB : cB + (size_t)(t + 2) * kstep;
            const char* a3 = a2 + kstep; const char* b3 = b2 + kstep;
            if (last && has_next) S.a_ready(nxt);
            if constexpr (SP2) {
            PG8_LDB(B0, 0, 0); PG8_LDB(B1, 0, 1); PG8_SCHED; PG8_LDA(At, 0, 0); PG8_STAGE(PG8_SA(1, 1), a1 + hstep, voffA);
            PG8_WAIT_V(8); PG8_WAIT_L(0); PG8_BAR; PG8_MMA(0, 0, At, B0); PG8_MMA(0, 1, At, B1); PG8_BAR; PG8_SCHED;
            PG8_LDA(At, 0, 1); PG8_STAGE(PG8_SB(0, 0), b2, voffB); PG8_STAGE(PG8_SB(0, 1), b2 + hstep, voffB); PG8_STAGE(PG8_SA(0, 0), a2, voffA);
            PG8_WAIT_V(8); PG8_WAIT_L(0); PG8_BAR; PG8_MMA(1, 0, At, B0); PG8_MMA(1, 1, At, B1); PG8_BAR; PG8_SCHED;
            PG8_LDB(B0, 1, 0); PG8_LDB(B1, 1, 1); PG8_SCHED; PG8_LDA(At, 1, 0); PG8_STAGE(PG8_SA(0, 1), a2 + hstep, voffA);
            PG8_WAIT_V(8); PG8_WAIT_L(0); PG8_BAR; PG8_MMA(0, 0, At, B0); PG8_MMA(0, 1, At, B1); PG8_BAR; PG8_SCHED;
            PG8_LDA(At, 1, 1); PG8_STAGE(PG8_SB(1, 0), b3, voffB); PG8_STAGE(PG8_SB(1, 1), b3 + hstep, voffB); PG8_STAGE(PG8_SA(1, 0), a3, voffA);
            PG8_WAIT_V(8); PG8_WAIT_L(0); PG8_BAR; PG8_MMA(1, 0, At, B0); PG8_MMA(1, 1, At, B1); PG8_BAR; PG8_SCHED;
            } else {
            PG8_LDB(B0, 0, 0); PG8_SCHED; PG8_LDA(At, 0, 0); PG8_STAGE(PG8_SA(1, 1), a1 + hstep, voffA);
            PG8_WAIT_L(8); PG8_BAR; PG8_WAIT_L(0); PG8_MMA(0, 0, At, B0); PG8_BAR; PG8_SCHED;
            PG8_LDB(B1, 0, 1); PG8_STAGE(PG8_SB(0, 0), b2, voffB);
            PG8_BAR; PG8_WAIT_L(0); PG8_MMA(0, 1, At, B1); PG8_BAR;
            PG8_LDA(At, 0, 1); PG8_STAGE(PG8_SA(0, 0), a2, voffA);
            PG8_BAR; PG8_WAIT_L(0); PG8_MMA(1, 0, At, B0); PG8_BAR; PG8_SCHED;
            PG8_STAGE(PG8_SB(0, 1), b2 + hstep, voffB);
            PG8_WAIT_V(6); PG8_BAR; PG8_MMA(1, 1, At, B1); PG8_BAR;
            PG8_LDB(B0, 1, 0); PG8_SCHED; PG8_LDA(At, 1, 0); PG8_STAGE(PG8_SA(0, 1), a2 + hstep, voffA);
            PG8_WAIT_L(8); PG8_BAR; PG8_WAIT_L(0); PG8_MMA(0, 0, At, B0); PG8_BAR; PG8_SCHED;
            PG8_LDB(B1, 1, 1); PG8_STAGE(PG8_SB(1, 0), b3, voffB);
            PG8_BAR; PG8_WAIT_L(0); PG8_MMA(0, 1, At, B1); PG8_BAR;
            PG8_LDA(At, 1, 1); PG8_STAGE(PG8_SA(1, 0), a3, voffA);
            PG8_BAR; PG8_WAIT_L(0); PG8_MMA(1, 0, At, B0); PG8_BAR; PG8_SCHED;
            PG8_STAGE(PG8_SB(1, 1), b3 + hstep, voffB);
            PG8_WAIT_V(6); PG8_BAR; PG8_MMA(1, 1, At, B1); PG8_BAR;
            }
        }
        if constexpr (ALIGN_EPI) { if (wr == 0) PG8_BAR; }
        if constexpr (!Epi::AFTER_DRAIN) { E(acc, cur, wr, wc, fr, fq); S.done(cur); }
        if (!has_next) break;
#pragma unroll
        for (int a = 0; a < 2; ++a)
#pragma unroll
            for (int b = 0; b < 2; ++b)
#pragma unroll
                for (int m = 0; m < 4; ++m)
#pragma unroll
                    for (int n = 0; n < 2; ++n) acc[a][b][m][n] = (f32x4){0.f, 0.f, 0.f, 0.f};
        cur = nxt; cA = nA; cB = nB; ++ui;
        if constexpr (ALIGN_EPI) { if (wr == 1) PG8_BAR; }
    }
    PG8_WAIT_V(0);
    if constexpr (!ALIGN_EPI) { if (wr == 0) PG8_BAR; }
    PG8_BAR;
    if constexpr (Epi::AFTER_DRAIN) { E.fused(acc, cur, wr, wc, fr, fq, lds, wid, lane); S.done(cur); }
#undef PG8_SA
#undef PG8_SB
#undef PG8_STAGE
#undef PG8_LDA
#undef PG8_LDB
#undef PG8_MMA
#undef PG8_WAIT_V
#undef PG8_WAIT_L
#undef PG8_BAR
#undef PG8_SCHED
}
}
namespace att {
using bf16 = unsigned short;
using bf16x8 = __attribute__((ext_vector_type(8))) short;
using s16x4  = __attribute__((ext_vector_type(4))) short;
using f32x16 = __attribute__((ext_vector_type(16))) float;
using u32x4  = __attribute__((ext_vector_type(4))) unsigned;
constexpr int KVBLK = 64, LDP = 4608, LDO = 2048;
constexpr int SHM_V = 16384, SHM_K = 16384;
constexpr int SLOT = SHM_V + SHM_K, NSLOT = 3;
constexpr int OFF_V = 0, OFF_K = SHM_V, OFF_WS = NSLOT * SLOT, OFF_TAB = OFF_WS + 8 * 64 * 4, ATT_LDS = OFF_TAB + 272 * 4;
constexpr float LOG2E = 1.4426950408889634f;
constexpr float THR = 8.f;
constexpr float NEGB = -1e30f;
#define KSWZ(row, colB) ((row) * 256 + ((colB) ^ (((row) & 7) << 4)))
#define SBAR() __builtin_amdgcn_sched_barrier(0)
__device__ __forceinline__ int crow(int r, int hi) { return (r & 3) + 8 * (r >> 2) + 4 * hi; }
__device__ __forceinline__ unsigned cvtpk(float lo, float hi) { unsigned r; asm volatile("v_cvt_pk_bf16_f32 %0, %1, %2" : "=v"(r) : "v"(lo), "v"(hi)); return r; }
__device__ __forceinline__ bf16x8 ld8(const bf16* p) { return *reinterpret_cast<const bf16x8*>(p); }

__device__ __forceinline__ float max3f(float a, float b, float c) { float r; asm("v_max3_f32 %0, %1, %2, %3" : "=v"(r) : "v"(a), "v"(b), "v"(c)); return r; }
__device__ __forceinline__ int t5_bucket(int rel) {
  const int n = rel < 0 ? -rel : rel; int b;
  if (n < 8) b = n; else { int l = (31 - __builtin_clz((unsigned)(n * n))) - 6; b = 8 + l; if (b > 15) b = 15; }
  return (rel > 0 ? 16 : 0) + b;
}

__device__ __forceinline__ void partialSM(f32x16& p0, f32x16& p1, float& m_reg, float& alpha, float Ce, float be) {
  float pmax = max3f(p0[0], p0[1], p1[0]), pmb = max3f(p0[2], p0[3], p1[1]);
  pmax = max3f(pmax, p1[2], p1[3]);
#pragma unroll
  for (int r = 4; r < 16; r += 4) { pmax = max3f(pmax, p0[r], p0[r + 1]); pmb = max3f(pmb, p0[r + 2], p0[r + 3]); pmax = max3f(pmax, p1[r], p1[r + 1]); pmb = max3f(pmb, p1[r + 2], p1[r + 3]); }
  pmax = max3f(pmax, pmb, pmb);
  { auto rr = __builtin_amdgcn_permlane32_swap(__float_as_uint(pmax), __float_as_uint(pmax), false, false);
    pmax = fmaxf(__uint_as_float(rr[0]), __uint_as_float(rr[1])); }
  pmax = fmaf(pmax, Ce, be);
  float mn;
  if (__builtin_expect(__all(pmax - m_reg <= THR), 1)) { mn = m_reg; alpha = 1.f; }
  else { mn = fmaxf(m_reg, pmax); alpha = __builtin_amdgcn_exp2f(m_reg - mn); m_reg = mn; }
  const float off = be - mn;
#pragma unroll
  for (int r = 0; r < 16; ++r) p0[r] = fmaf(p0[r], Ce, off);
#pragma unroll
  for (int r = 0; r < 16; ++r) p1[r] = fmaf(p1[r], Ce, off);
#pragma unroll
  for (int r = 0; r < 16; ++r) p0[r] = __builtin_amdgcn_exp2f(p0[r]);
}
__device__ __forceinline__ void finishSM(f32x16& p0, f32x16& p1, float alpha, float& l_reg, bf16x8& pa0, bf16x8& pa1, bf16x8& pa2, bf16x8& pa3) {
#pragma unroll
  for (int r = 0; r < 16; ++r) p1[r] = __builtin_amdgcn_exp2f(p1[r]);
  float ps = 0;
#pragma unroll
  for (int r = 0; r < 16; ++r) ps += p0[r];
#pragma unroll
  for (int r = 0; r < 16; ++r) ps += p1[r];
  { auto rr = __builtin_amdgcn_permlane32_swap(__float_as_uint(ps), __float_as_uint(ps), false, false);
    ps = __uint_as_float(rr[0]) + __uint_as_float(rr[1]); }
  l_reg = l_reg * alpha + ps;
#define PK4(P, BASE, OUT) do { unsigned a0 = cvtpk(P[BASE + 0], P[BASE + 1]), a1 = cvtpk(P[BASE + 2], P[BASE + 3]);   \
    unsigned b0 = cvtpk(P[BASE + 4], P[BASE + 5]), b1 = cvtpk(P[BASE + 6], P[BASE + 7]);                              \
    auto r0 = __builtin_amdgcn_permlane32_swap(a0, b0, false, false); auto r1 = __builtin_amdgcn_permlane32_swap(a1, b1, false, false); \
    u32x4 w = {r0[0], r1[0], r0[1], r1[1]}; OUT = *reinterpret_cast<bf16x8*>(&w); } while (0)
  PK4(p0, 0, pa0); PK4(p0, 8, pa1); PK4(p1, 0, pa2); PK4(p1, 8, pa3);
#undef PK4
}
__device__ __forceinline__ bf16x8 scale_bf16x8(bf16x8 v, float c) {
  u32x4 w = *reinterpret_cast<u32x4*>(&v), o;
#pragma unroll
  for (int i = 0; i < 4; ++i) { const float lo = __uint_as_float(w[i] << 16), hh = __uint_as_float(w[i] & 0xffff0000u); o[i] = cvtpk(lo * c, hh * c); }
  return *reinterpret_cast<bf16x8*>(&o);
}
template <int ND0> __device__ __forceinline__ void qkt(f32x16& p0, f32x16& p1, const char* Ks, const bf16x8* qr, int r32, int hi, int cboff, const f32x16& ci) {
#pragma unroll
  for (int d0 = 0; d0 < ND0; ++d0) { int cb = cboff + (d0 * 16 + hi * 8) * 2;
    bf16x8 b0 = *reinterpret_cast<const bf16x8*>(Ks + KSWZ(r32, cb));
    bf16x8 b1 = *reinterpret_cast<const bf16x8*>(Ks + KSWZ(32 + r32, cb));
    if (d0 == 0) { p0 = __builtin_amdgcn_mfma_f32_32x32x16_bf16(b0, qr[0], ci, 0, 0, 0); p1 = __builtin_amdgcn_mfma_f32_32x32x16_bf16(b1, qr[0], ci, 0, 0, 0); }
    else { p0 = __builtin_amdgcn_mfma_f32_32x32x16_bf16(b0, qr[d0], p0, 0, 0, 0); p1 = __builtin_amdgcn_mfma_f32_32x32x16_bf16(b1, qr[d0], p1, 0, 0, 0); } }
}
template <bool FIRST> __device__ __forceinline__ void partialSM2(f32x16& p0, f32x16& p1, float& m_ref, f32x16& negm, float& alpha) {
  float pmax = max3f(p0[0], p0[1], p1[0]), pmb = max3f(p0[2], p0[3], p1[1]);
  pmax = max3f(pmax, p1[2], p1[3]);
#pragma unroll
  for (int r = 4; r < 16; r += 4) { pmax = max3f(pmax, p0[r], p0[r + 1]); pmb = max3f(pmb, p0[r + 2], p0[r + 3]); pmax = max3f(pmax, p1[r], p1[r + 1]); pmb = max3f(pmb, p1[r + 2], p1[r + 3]); }
  pmax = max3f(pmax, pmb, pmb);
  { auto rr = __builtin_amdgcn_permlane32_swap(__float_as_uint(pmax), __float_as_uint(pmax), false, false);
    pmax = fmaxf(__uint_as_float(rr[0]), __uint_as_float(rr[1])); }
  alpha = 1.f;
  if (FIRST || !__builtin_expect(__all(pmax <= THR), 1)) {
    const float dl = FIRST ? pmax : fmaxf(pmax, 0.f); m_ref += dl; if (!FIRST) alpha = __builtin_amdgcn_exp2f(-dl);
#pragma unroll
    for (int r = 0; r < 16; ++r) { p0[r] -= dl; p1[r] -= dl; negm[r] -= dl; }
  }
#pragma unroll
  for (int r = 0; r < 16; ++r) p0[r] = __builtin_amdgcn_exp2f(p0[r]);
}
__device__ __forceinline__ int v_st(int k, int c) { const int kk = (k & ~0xC) | ((k & 4) << 1) | ((k & 8) >> 1); return ((kk >> 3) * 4 + (c >> 5)) * 512 + ((kk & 7) * 32 + (c & 31)) * 2; }
__device__ __forceinline__ int v_rd_base(int lane) { return ((lane & 3) << 3) | (((lane >> 2) & 3) << 6) | (((lane >> 4) & 1) << 5) | (((lane >> 5) & 1) << 8); }
constexpr int v_rd_off(int d0, int ks, int half) { return d0 * 512 + ks * 4096 + half * 2048; }
template <int OFF> __device__ __forceinline__ s16x4 tr_read(int vb) {
  s16x4 r; asm volatile("ds_read_b64_tr_b16 %0, %1 offset:%2" : "=&v"(r) : "v"(vb), "i"(OFF) : "memory"); return r;
}
#define VRD8(D0, L0, H0, L1, H1, L2, H2, L3, H3) do { L0 = tr_read<v_rd_off(D0, 0, 0)>(vb); H0 = tr_read<v_rd_off(D0, 0, 1)>(vb); L1 = tr_read<v_rd_off(D0, 1, 0)>(vb); H1 = tr_read<v_rd_off(D0, 1, 1)>(vb); \
    L2 = tr_read<v_rd_off(D0, 2, 0)>(vb); H2 = tr_read<v_rd_off(D0, 2, 1)>(vb); L3 = tr_read<v_rd_off(D0, 3, 0)>(vb); H3 = tr_read<v_rd_off(D0, 3, 1)>(vb); } while (0)
#define PK(L, H) (bf16x8){L[0], L[1], L[2], L[3], H[0], H[1], H[2], H[3]}
#define MMA4(OD, L0, H0, L1, H1, L2, H2, L3, H3) do { OD = __builtin_amdgcn_mfma_f32_32x32x16_bf16(pa0, PK(L0, H0), OD, 0, 0, 0); OD = __builtin_amdgcn_mfma_f32_32x32x16_bf16(pa1, PK(L1, H1), OD, 0, 0, 0); \
    OD = __builtin_amdgcn_mfma_f32_32x32x16_bf16(pa2, PK(L2, H2), OD, 0, 0, 0); OD = __builtin_amdgcn_mfma_f32_32x32x16_bf16(pa3, PK(L3, H3), OD, 0, 0, 0); } while (0)
__device__ __forceinline__ void pv_d0(f32x16* o, int vb, bf16x8 pa0, bf16x8 pa1, bf16x8 pa2, bf16x8 pa3) {
  s16x4 a0, a1, a2, a3, a4, a5, a6, a7, b0, b1, b2, b3, b4, b5, b6, b7;
  VRD8(0, a0, a1, a2, a3, a4, a5, a6, a7);
  VRD8(1, b0, b1, b2, b3, b4, b5, b6, b7);
  asm volatile("s_waitcnt lgkmcnt(8)" ::: "memory"); SBAR();
  MMA4(o[0], a0, a1, a2, a3, a4, a5, a6, a7); SBAR();
  VRD8(2, a0, a1, a2, a3, a4, a5, a6, a7);
  asm volatile("s_waitcnt lgkmcnt(8)" ::: "memory"); SBAR();
  MMA4(o[1], b0, b1, b2, b3, b4, b5, b6, b7); SBAR();
  VRD8(3, b0, b1, b2, b3, b4, b5, b6, b7);
  asm volatile("s_waitcnt lgkmcnt(8)" ::: "memory"); SBAR();
  MMA4(o[2], a0, a1, a2, a3, a4, a5, a6, a7); SBAR();
  asm volatile("s_waitcnt lgkmcnt(0)" ::: "memory"); SBAR();
  MMA4(o[3], b0, b1, b2, b3, b4, b5, b6, b7);
}
__device__ __forceinline__ void pv_partial(f32x16* o, int vb, bf16x8 pa0, bf16x8 pa1, bf16x8 pa2, bf16x8 pa3, f32x16& p0, f32x16& p1, float& m_ref, f32x16& negm, float& alpha) {
  s16x4 a0, a1, a2, a3, a4, a5, a6, a7, b0, b1, b2, b3, b4, b5, b6, b7;
  VRD8(0, a0, a1, a2, a3, a4, a5, a6, a7);
  VRD8(1, b0, b1, b2, b3, b4, b5, b6, b7);
  asm volatile("s_waitcnt lgkmcnt(8)" ::: "memory"); SBAR();
  MMA4(o[0], a0, a1, a2, a3, a4, a5, a6, a7);
  float pmax = max3f(p0[0], p0[1], p1[0]), pmb = max3f(p0[2], p0[3], p1[1]);
  pmax = max3f(pmax, p1[2], p1[3]);
#pragma unroll
  for (int r = 4; r < 16; r += 4) { pmax = max3f(pmax, p0[r], p0[r + 1]); pmb = max3f(pmb, p0[r + 2], p0[r + 3]); pmax = max3f(pmax, p1[r], p1[r + 1]); pmb = max3f(pmb, p1[r + 2], p1[r + 3]); }
  pmax = max3f(pmax, pmb, pmb);
  SBAR();
  VRD8(2, a0, a1, a2, a3, a4, a5, a6, a7);
  asm volatile("s_waitcnt lgkmcnt(8)" ::: "memory"); SBAR();
  MMA4(o[1], b0, b1, b2, b3, b4, b5, b6, b7);
  { auto rr = __builtin_amdgcn_permlane32_swap(__float_as_uint(pmax), __float_as_uint(pmax), false, false);
    pmax = fmaxf(__uint_as_float(rr[0]), __uint_as_float(rr[1])); }
  alpha = 1.f;
  if (!__builtin_expect(__all(pmax <= THR), 1)) {
    const float dl = fmaxf(pmax, 0.f); m_ref += dl; alpha = __builtin_amdgcn_exp2f(-dl);
#pragma unroll
    for (int r = 0; r < 16; ++r) { p0[r] -= dl; p1[r] -= dl; negm[r] -= dl; }
  }
  SBAR();
  VRD8(3, b0, b1, b2, b3, b4, b5, b6, b7);
  asm volatile("s_waitcnt lgkmcnt(8)" ::: "memory"); SBAR();
  MMA4(o[2], a0, a1, a2, a3, a4, a5, a6, a7);
#pragma unroll
  for (int r = 0; r < 8; ++r) p0[r] = __builtin_amdgcn_exp2f(p0[r]);
  SBAR();
  asm volatile("s_waitcnt lgkmcnt(0)" ::: "memory"); SBAR();
  MMA4(o[3], b0, b1, b2, b3, b4, b5, b6, b7);
#pragma unroll
  for (int r = 8; r < 16; ++r) p0[r] = __builtin_amdgcn_exp2f(p0[r]);
}
#undef VRD8
#undef PK
#undef MMA4

template <int MODE, int ORD>
__device__ __forceinline__ void attn_unit(const bf16* __restrict__ Qb, const bf16* __restrict__ Kh, const bf16* __restrict__ Vh, bf16* __restrict__ Ob,
                                          int qpos0, int kbeg, int NT, const float* __restrict__ tabsrc, float sinkv, float lam, float oscale,
                                          const float* __restrict__ subg, char* lds) {
  constexpr int ND0 = MODE == 0 ? 4 : 8;
  const float C = (MODE == 0 ? 0.125f : 0.08838834764831845f) * LOG2E;
  int tid_ = threadIdx.x; asm volatile("" : "+v"(tid_));
  const int tid = tid_, wid = __builtin_amdgcn_readfirstlane(tid >> 6), lane = tid & 63; int r32 = lane & 31, hi = lane >> 5;
  const int wq = MODE == 0 ? (wid & 3) : wid, cst = MODE == 0 ? (wid >> 2) : 0;
  char* V_lds = lds + OFF_V; char* K_lds = lds + OFF_K;
  float* wsf = (float*)(lds + OFF_WS) + wid * 64; float* li_l = wsf; float* al_l = wsf + 32;
  float* tab = (float*)(lds + OFF_TAB);
  __syncthreads();
  if (wid >= 4) __builtin_amdgcn_s_setprio(1);
  if (tid < 257) tab[tid] = tabsrc[t5_bucket(tid - 128) * 16] * LOG2E;
  float m_reg = MODE == 0 ? 0.f : sinkv * LOG2E, l_reg = MODE == 0 ? 0.f : 1.f;
  f32x16 o[4] = {}; bf16x8 qr[ND0];
  const bf16* Qw = Qb + (long)(wq * 32 + r32) * LDP + cst * 64 + hi * 8;
#pragma unroll
  for (int d0 = 0; d0 < ND0; ++d0) qr[d0] = scale_bf16x8(ld8(Qw + d0 * 16), C);
  const int qpos = qpos0 + wq * 32 + r32;
  const int qw0 = qpos0 + wq * 32;
  const int cboff = cst * 128;
  int sr = tid >> 4, sc = (tid & 15) * 8, vst0 = v_st(sr, sc), vst1 = v_st(32 + sr, sc);
  int vb0 = (int)(uintptr_t)V_lds + v_rd_base(lane);
  const bf16* Kg = Kh + (long)kbeg * LDP; const bf16* Vg = Vh + (long)kbeg * LDP;
  struct { bf16x8 vs0, vs1, ks0, ks1; } sr_[1];
#define SLOAD(i, k0) do { sr_[i].vs0 = ld8(&Vg[(long)((k0) + sr) * LDP + sc]); sr_[i].vs1 = ld8(&Vg[(long)((k0) + 32 + sr) * LDP + sc]); \
    sr_[i].ks0 = ld8(&Kg[(long)((k0) + sr) * LDP + sc]); sr_[i].ks1 = ld8(&Kg[(long)((k0) + 32 + sr) * LDP + sc]); } while (0)
#define SWRITE(off, i) do { *(bf16x8*)(V_lds + (off) + vst0) = sr_[i].vs0;          \
    *(bf16x8*)(V_lds + (off) + vst1) = sr_[i].vs1; int kc = sc * 2;               \
    *(bf16x8*)(K_lds + (off) + KSWZ(sr, kc)) = sr_[i].ks0;                       \
    *(bf16x8*)(K_lds + (off) + KSWZ(32 + sr, kc)) = sr_[i].ks1; } while (0)
#define SWAIT() asm volatile("s_waitcnt vmcnt(0)" ::: "memory")
#define RESC(a) do { if (__any((a) < 1.f)) { if (hi == 0) al_l[r32] = (a); asm volatile("s_waitcnt lgkmcnt(0)" ::: "memory"); \
    _Pragma("unroll") for (int d = 0; d < 4; ++d) _Pragma("unroll") for (int r = 0; r < 16; ++r) o[d][r] *= al_l[crow(r, hi)]; } } while (0)
  float bL, bR, be_cur = 0.f; f32x16 negm;
#pragma unroll
  for (int r = 0; r < 16; ++r) negm[r] = -m_reg;
#define TCLS(t) const int k0_ = kbeg + (t) * KVBLK; const int rmax_ = k0_ + 63 - qw0, rmin_ = k0_ - qw0 - 31; const bool near_ = (MODE == 1) || (rmax_ > -128 && rmin_ < 128)
#define SETBE(t) do { TCLS(t); const float bt_ = near_ ? 0.f : ((rmax_ <= -128) ? bL : bR); \
    if (bt_ != be_cur) { const float d_ = bt_ - be_cur; _Pragma("unroll") for (int r = 0; r < 16; ++r) negm[r] += d_; be_cur = bt_; } } while (0)
#define BIAS(P0, P1, t) do { TCLS(t); (void)rmin_; (void)rmax_; \
    if (near_) { asm volatile("" ::: "memory");     \
      const int base_ = k0_ - qpos + 128 + 4 * hi; \
      _Pragma("unroll") for (int r = 0; r < 16; ++r) { const int i0 = base_ + (r & 3) + 8 * (r >> 2), i1 = i0 + 32; \
        const int c0 = i0 < 0 ? 0 : (i0 > 256 ? 256 : i0), c1 = i1 < 0 ? 0 : (i1 > 256 ? 256 : i1); \
        const float t0 = P0[r] + tab[c0], t1 = P1[r] + tab[c1]; \
        if (MODE == 1) { P0[r] = (i0 == c0) ? t0 : NEGB; P1[r] = (i1 == c1) ? t1 : NEGB; } else { P0[r] = t0; P1[r] = t1; } } \
      asm volatile("" ::: "memory"); } } while (0)
  f32x16 pA0, pA1, pB0, pB1; float alA, alB; bf16x8 pa0, pa1, pa2, pa3;
  constexpr int SE = 0, SO = 0;
  SLOAD(SE, 0); asm volatile("s_waitcnt vmcnt(0)" ::: "memory"); SWRITE(0, SE); __syncthreads();
  bL = tab[0]; bR = tab[256];
  SETBE(0); qkt<ND0>(pA0, pA1, K_lds, qr, r32, hi, cboff, negm); BIAS(pA0, pA1, 0); partialSM2<MODE == 0>(pA0, pA1, m_reg, negm, alA);
  SLOAD(SO, KVBLK);
  SWAIT(); SWRITE(SLOT, SO); __syncthreads();
  int op = 0, oc = SLOT, on = 2 * SLOT;
#define ROT() do { const int t_ = op; op = oc; oc = on; on = t_; } while (0)
#define TILE_STEP1(PN0, PN1, ALN, PO0, PO1, ALO, TN, LOADS) do { \
      SBAR(); finishSM(PO0, PO1, ALO, l_reg, pa0, pa1, pa2, pa3); SBAR(); LOADS; SETBE(TN); SBAR(); qkt<ND0>(PN0, PN1, K_lds + oc, qr, r32, hi, cboff, negm); SBAR(); \
      BIAS(PN0, PN1, TN); partialSM2<false>(PN0, PN1, m_reg, negm, ALN); SBAR(); pv_d0(o, vb0 + op, pa0, pa1, pa2, pa3); } while (0)
#define MAIN_LOOP(TS) do { \
  for (int j = 1; j + 1 < NT; j += 2) { \
    TS(pB0, pB1, alB, pA0, pA1, alA, j, SLOAD(SO, (j + 1) * KVBLK)); \
    SWAIT(); SWRITE(on, SE); RESC(alB); __syncthreads(); ROT(); \
    TS(pA0, pA1, alA, pB0, pB1, alB, j + 1, SLOAD(SE, (j + 2) * KVBLK)); \
    SWAIT(); SWRITE(on, SO); RESC(alA); __syncthreads(); ROT(); \
  } \
  TS(pB0, pB1, alB, pA0, pA1, alA, NT - 1, (void)0); } while (0)
#define TILE_STEPX(PN0, PN1, ALN, PO0, PO1, ALO, TN, LOADS) do { \
      SBAR(); LOADS; SETBE(TN); SBAR(); qkt<ND0>(PN0, PN1, K_lds + oc, qr, r32, hi, cboff, negm); finishSM(PO0, PO1, ALO, l_reg, pa0, pa1, pa2, pa3); SBAR(); \
      BIAS(PN0, PN1, TN); SBAR(); pv_partial(o, vb0 + op, pa0, pa1, pa2, pa3, PN0, PN1, m_reg, negm, ALN); } while (0)
  MAIN_LOOP(TILE_STEPX);
#undef MAIN_LOOP
#undef TILE_STEPX
#undef TILE_STEP1
#undef SETBE
#undef TCLS
  RESC(alB);
  finishSM(pB0, pB1, alB, l_reg, pa0, pa1, pa2, pa3); SBAR();
  pv_d0(o, vb0 + oc, pa0, pa1, pa2, pa3);
#undef ROT
  if (hi == 0) li_l[r32] = l_reg; asm volatile("s_waitcnt lgkmcnt(0)" ::: "memory");
  float rli[16];
#pragma unroll
  for (int r = 0; r < 16; ++r) rli[r] = __builtin_amdgcn_rcpf(li_l[crow(r, hi)]);
  if (MODE == 1) {
    bf16* Ow = Ob + (long)(wq * 32) * LDO;
#pragma unroll
    for (int r = 0; r < 16; ++r) { const int orow = crow(r, hi);
#pragma unroll
      for (int d0 = 0; d0 < 4; ++d0) { __hip_bfloat16 bv = __float2bfloat16(o[d0][r] * rli[r]); Ow[(long)orow * LDO + d0 * 32 + r32] = *reinterpret_cast<bf16*>(&bv); } }
  } else {
    __syncthreads();
    float* X = (float*)lds + wq * 4096;
    if (cst == 1) {
#pragma unroll
      for (int r = 0; r < 16; ++r) { const int orow = crow(r, hi);
#pragma unroll
        for (int d0 = 0; d0 < 4; ++d0) X[orow * 128 + d0 * 32 + r32] = o[d0][r] * rli[r]; }
    }
    __syncthreads();
    if (cst == 0) {
      float ssq[16];
#pragma unroll
      for (int r = 0; r < 16; ++r) { const int orow = crow(r, hi); float s = 0.f;
#pragma unroll
        for (int d0 = 0; d0 < 4; ++d0) { const float v = o[d0][r] * rli[r] - lam * X[orow * 128 + d0 * 32 + r32]; o[d0][r] = v; s = fmaf(v, v, s); }
        ssq[r] = s; }
#pragma unroll
      for (int r = 0; r < 16; ++r) {
#pragma unroll
        for (int off = 1; off < 32; off <<= 1) ssq[r] += __shfl_xor(ssq[r], off);
      }
      float gg[4];
#pragma unroll
      for (int d0 = 0; d0 < 4; ++d0) gg[d0] = subg[d0 * 32 + r32] * oscale;
      bf16* Ow = Ob + (long)(wq * 32) * LDO;
#pragma unroll
      for (int r = 0; r < 16; ++r) { const int orow = crow(r, hi); const float rs = __builtin_amdgcn_rsqf(ssq[r] * (1.f / 128.f) + 1e-6f);
#pragma unroll
        for (int d0 = 0; d0 < 4; ++d0) { __hip_bfloat16 bv = __float2bfloat16(o[d0][r] * rs * gg[d0]); Ow[(long)orow * LDO + d0 * 32 + r32] = *reinterpret_cast<bf16*>(&bv); } }
    }
  }
  __builtin_amdgcn_s_setprio(0);
#undef SLOAD
#undef SWRITE
#undef SWAIT
#undef RESC
#undef BIAS
}
#undef SBAR
}

#define LAS __attribute__((address_space(3)))
typedef unsigned short bf16;
typedef unsigned v4u __attribute__((ext_vector_type(4)));
typedef float f32x4 __attribute__((ext_vector_type(4)));
constexpr int NWAVES = 8;
constexpr int DM = 2048, SEQ_P = 8192, NB_P = 4, SEQ_S = 4096, NB_S = 2, DEPTH = 2, DFF = 8192, INW = 4608;
constexpr int M_P = NB_P * SEQ_P, M_S = NB_S * SEQ_S, M = M_P + M_S;
constexpr size_t MiB = 1u << 20;
constexpr size_t WS_WIN = 1 * MiB;
constexpr size_t WS_WOUT = WS_WIN + (size_t)DEPTH * INW * DM * 2;
constexpr size_t WS_WF1 = WS_WOUT + (size_t)DEPTH * DM * DM * 2;
constexpr size_t WS_WF2 = WS_WF1 + (size_t)DEPTH * DFF * DM * 2;
constexpr size_t WS_XN = WS_WF2 + (size_t)DEPTH * DM * DFF * 2;
constexpr size_t WS_H = WS_XN + (size_t)M * DM * 2;
constexpr size_t WS_PROJ = WS_H;
constexpr size_t WS_ATT = WS_PROJ + (size_t)M * INW * 2;
constexpr size_t WS_END = WS_H + (size_t)M * DFF * 2;
static_assert(WS_ATT + (size_t)M * DM * 2 <= WS_END, "overlay");
constexpr int LDS_BYTES = 147456;
static_assert(att::ATT_LDS <= 131072, "attention LDS");

__device__ __forceinline__ unsigned f2bf(float f) { unsigned u = __builtin_bit_cast(unsigned, f); return (u + 0x7fffu + ((u >> 16) & 1u)) >> 16; }
__device__ __forceinline__ unsigned pk2(float lo, float hi) { return f2bf(lo) | (f2bf(hi) << 16); }
__device__ __forceinline__ float wave_sum(float v) {
#pragma unroll
    for (int o = 1; o < 64; o <<= 1) v += __shfl_xor(v, o);
    return v;
}
__device__ __forceinline__ void transpose_item(const float* W, int K, int N, bf16* WT, LAS float* scr, int item, int lane) {
    const int nblk = N / 32, kb = item / nblk, nb = item % nblk, k0 = 64 * kb, n0 = 32 * nb;
#pragma unroll 16
    for (int i = 0; i < 32; ++i) { const int kk = 2 * i + (lane >> 5); scr[kk * 33 + (lane & 31)] = W[(size_t)(k0 + kk) * N + n0 + (lane & 31)]; }
    asm volatile("s_waitcnt lgkmcnt(0)" ::: "memory");
    const int c = lane & 7;
#pragma unroll
    for (int j = 0; j < 4; ++j) { const int n = (lane >> 3) + 8 * j; const LAS float* s = scr + (8 * c) * 33 + n;
        v4u o; o.x = pk2(s[0 * 33], s[1 * 33]); o.y = pk2(s[2 * 33], s[3 * 33]); o.z = pk2(s[4 * 33], s[5 * 33]); o.w = pk2(s[6 * 33], s[7 * 33]);
        *(v4u*)(WT + (size_t)(n0 + n) * K + k0 + 8 * c) = o; }
    asm volatile("s_waitcnt lgkmcnt(0)" ::: "memory");
}
__device__ __forceinline__ float xg_row_bf16(const float* xrow, const float* g, bf16* orow, int lane) {
    const f32x4* xr = (const f32x4*)xrow + lane; const f32x4* gr = (const f32x4*)g + lane;
    f32x4 v[8]; float s = 0.f;
#pragma unroll
    for (int j = 0; j < 8; ++j) { v[j] = xr[64 * j]; s += (v[j].x * v[j].x + v[j].y * v[j].y) + (v[j].z * v[j].z + v[j].w * v[j].w); }
    unsigned long long* o8 = (unsigned long long*)orow + lane;
#pragma unroll
    for (int j = 0; j < 8; ++j) { const f32x4 gg = gr[64 * j]; o8[64 * j] = (unsigned long long)pk2(v[j].x * gg.x, v[j].y * gg.y) | ((unsigned long long)pk2(v[j].z * gg.z, v[j].w * gg.w) << 32); }
    return wave_sum(s);
}
struct Args { const float* in[16]; float* out; unsigned char* ws; int ph_lo, ph_hi; };
constexpr int N_PHASES = 2 + 5 * DEPTH;
constexpr size_t WS_SSQ = 0;

__global__ void __launch_bounds__(NWAVES * 64, 2) mega_fwd(Args args) {
    extern __shared__ __attribute__((aligned(16))) unsigned char lds[];
    cg::grid_group grid = cg::this_grid();
    const int tid = threadIdx.x, wave = __builtin_amdgcn_readfirstlane(tid >> 6); int lane = tid & 63;
#define LAUNDER() asm volatile("v_mbcnt_lo_u32_b32 %0, -1, 0\n\tv_mbcnt_hi_u32_b32 %0, -1, %0" : "=v"(lane))
    const int G = gridDim.x, bx = blockIdx.x;
    const int vcu = (G % 8 == 0) ? (bx % 8) * (G / 8) + bx / 8 : bx;
    const int gw = vcu * NWAVES + wave, NGW = G * NWAVES;
    unsigned char* ws = args.ws;
    const float* x_prompt = args.in[0]; const float* x_sample = args.in[1]; const float* rel_bias = args.in[2];
    const float* norm1_g = args.in[3]; const float* w_in = args.in[4];
    const float* lq1 = args.in[5]; const float* lk1 = args.in[6]; const float* lq2 = args.in[7]; const float* lk2 = args.in[8];
    const float* subln_g = args.in[9]; const float* sink = args.in[10]; const float* w_out = args.in[11]; const float* norm2_g = args.in[12];
    const float* w_f1 = args.in[13]; const float* w_f2 = args.in[14]; const float* fin_g = args.in[15];
    float* out = args.out;
    bf16* Win_t = (bf16*)(ws + WS_WIN); bf16* Wout_t = (bf16*)(ws + WS_WOUT); bf16* Wf1_t = (bf16*)(ws + WS_WF1); bf16* Wf2_t = (bf16*)(ws + WS_WF2);
    float* SSQ = (float*)(ws + WS_SSQ);
    bf16* XN = (bf16*)(ws + WS_XN); bf16* HB = (bf16*)(ws + WS_H); bf16* PROJ = (bf16*)(ws + WS_PROJ); bf16* ATT = (bf16*)(ws + WS_ATT);
    const int lo = args.ph_lo, hi = args.ph_hi;
#define IN(k) (lo <= (k) && (k) < hi)
#define SEAM(k) do { if (IN(k) && IN((k) + 1)) grid.sync(); } while (0)

    if (IN(0)) {
        LAUNDER();
        LAS float* scr = (LAS float*)((LAS unsigned char*)lds + wave * 16384);
        constexpr int I_IN = (DM / 64) * (INW / 32), I_OUT = (DM / 64) * (DM / 32), I_F1 = (DM / 64) * (DFF / 32), I_F2 = (DFF / 64) * (DM / 32);
        constexpr int I_L = I_IN + I_OUT + I_F1 + I_F2;
        for (int it = gw; it < DEPTH * I_L; it += NGW) {
            const int l = it / I_L; int r = it % I_L;
            if (r < I_IN) { transpose_item(w_in + (size_t)l * DM * INW, DM, INW, Win_t + (size_t)l * INW * DM, scr, r, lane); continue; } r -= I_IN;
            if (r < I_OUT) { transpose_item(w_out + (size_t)l * DM * DM, DM, DM, Wout_t + (size_t)l * DM * DM, scr, r, lane); continue; } r -= I_OUT;
            if (r < I_F1) { transpose_item(w_f1 + (size_t)l * DM * DFF, DM, DFF, Wf1_t + (size_t)l * DFF * DM, scr, r, lane); continue; } r -= I_F1;
            transpose_item(w_f2 + (size_t)l * DFF * DM, DFF, DM, Wf2_t + (size_t)l * DM * DFF, scr, r, lane);
        }
        for (int i = (vcu * NWAVES * 64 + tid); i < 4 * M; i += G * NWAVES * 64) SSQ[M + i] = 0.f;
        for (int m = gw; m < M; m += NGW) { const float* xr = m < M_P ? x_prompt + (size_t)m * DM : x_sample + (size_t)(m - M_P) * DM; const float sq = xg_row_bf16(xr, norm1_g, XN + (size_t)m * DM, lane); if (lane == 0) SSQ[m] = sq; }
    }
    SEAM(0);
#pragma unroll
    for (int l = 0; l < DEPTH; ++l) {
        const int pb = 1 + 5 * l;
        if (IN(pb)) {
            pg8::Gemm g{XN, Win_t + (size_t)l * INW * DM, M, INW, DM}; pg8::StaticOrder S; S.init(M, INW, G, bx);
            pg8::EpiBf16<0> E{PROJ, INW, SSQ + (size_t)(2 * l) * M};
            pg8::gemm_phase<pg8::EpiBf16<0>, pg8::StaticOrder, true, true>((LAS unsigned char*)lds, g, S, E);
        }
        SEAM(pb);
        if (IN(pb + 1)) {
            LAUNDER();
            const float lambda_init = l == 0 ? 0.2f : (l == 1 ? 0.35550906758f : 0.8f - 0.6f * expf(-0.3f * (float)l));
            float d1 = lq1[l * 64 + lane] * lk1[l * 64 + lane], d2 = lq2[l * 64 + lane] * lk2[l * 64 + lane];
            d1 = wave_sum(d1); d2 = wave_sum(d2);
            const float lam = __uint_as_float(__builtin_amdgcn_readfirstlane(__float_as_uint(expf(d1) - expf(d2) + lambda_init)));
            const float oscl = __uint_as_float(__builtin_amdgcn_readfirstlane(__float_as_uint(1.f - lambda_init)));
#pragma unroll 1
            for (int U = vcu; U < 2560; U += G) {
                int pair, qb, S; size_t row0;
                if (U < 2048) { const int r = U >> 8, v = U & 255, x = v >> 5, cu = v & 31; pair = x * 4 + (r >> 1); qb = (r & 1) * 32 + cu; S = SEQ_P; row0 = (size_t)(pair >> 3) * SEQ_P; }
                else { const int U2 = U - 2048; const int r = U2 >> 8, v = U2 & 255, x = v >> 5, cu = v & 31; pair = x * 2 + r; qb = cu; S = SEQ_S; row0 = (size_t)M_P + (size_t)(pair >> 3) * SEQ_S; }
                const int h = pair & 7;
                if (false) att::attn_unit<0, 0>(PROJ + (row0 + qb * 128) * INW + h * 128, PROJ + row0 * INW + 1024 + h * 128, PROJ + row0 * INW + 2048 + h * 128,
                                  ATT + (row0 + qb * 128) * DM + h * 128, qb * 128, 0, S / 64, rel_bias + h, 0.f, lam, oscl, subln_g + l * 128, (char*)lds);
                else att::attn_unit<0, 1>(PROJ + (row0 + qb * 128) * INW + h * 128, PROJ + row0 * INW + 1024 + h * 128, PROJ + row0 * INW + 2048 + h * 128,
                                  ATT + (row0 + qb * 128) * DM + h * 128, qb * 128, 0, S / 64, rel_bias + h, 0.f, lam, oscl, subln_g + l * 128, (char*)lds);
            }
#pragma unroll 1
            for (int U3 = vcu; U3 < 1280; U3 += G) {
                const int r = U3 >> 8, v = U3 & 255; const int w = v * 5 + r; const int rbk = w >> 3, hq = w & 7, kvh = hq >> 2;
                const size_t grow = (size_t)rbk * 256;
                const bool isP = grow < (size_t)M_P; const int S = isP ? SEQ_P : SEQ_S;
                const size_t row0 = isP ? (grow / SEQ_P) * SEQ_P : (size_t)M_P + ((grow - M_P) / SEQ_S) * SEQ_S;
                const int q0 = (int)(grow - row0);
                const int kb = q0 - 128 < 0 ? 0 : q0 - 128, ke = q0 + 384 > S ? S : q0 + 384;
                if (false) att::attn_unit<1, 0>(PROJ + grow * INW + 3072 + hq * 128, PROJ + row0 * INW + 4096 + kvh * 128, PROJ + row0 * INW + 4352 + kvh * 128,
                                  ATT + grow * DM + 1024 + hq * 128, q0, kb, (ke - kb) / 64, rel_bias + 8 + hq, sink[l * 8 + hq], 0.f, 1.f, nullptr, (char*)lds);
                else att::attn_unit<1, 1>(PROJ + grow * INW + 3072 + hq * 128, PROJ + row0 * INW + 4096 + kvh * 128, PROJ + row0 * INW + 4352 + kvh * 128,
                                  ATT + grow * DM + 1024 + hq * 128, q0, kb, (ke - kb) / 64, rel_bias + 8 + hq, sink[l * 8 + hq], 0.f, 1.f, nullptr, (char*)lds);
            }
            __syncthreads();
        }
        SEAM(pb + 1);
        if (IN(pb + 2)) {
            pg8::Gemm g{ATT, Wout_t + (size_t)l * DM * DM, M, DM, DM}; pg8::StaticOrder S; S.init(M, DM, G, bx);
            pg8::EpiResF32 E{l == 0 ? x_prompt : out, l == 0 ? x_sample : out + (size_t)M_P * DM, M_P, out, XN, norm2_g + l * DM, SSQ + (size_t)(2 * l + 1) * M, nullptr};
            pg8::gemm_phase<pg8::EpiResF32, pg8::StaticOrder, true, true>((LAS unsigned char*)lds, g, S, E);
        }
        SEAM(pb + 2);
        if (IN(pb + 3)) {
            pg8::Gemm g{XN, Wf1_t + (size_t)l * DFF * DM, M, DFF, DM}; pg8::StaticOrder S; S.init(M, DFF, G, bx);
            pg8::EpiBf16<1> E{HB, DFF, nullptr};
            pg8::gemm_phase<pg8::EpiBf16<1>, pg8::StaticOrder, true, true>((LAS unsigned char*)lds, g, S, E);
        }
        SEAM(pb + 3);
        if (IN(pb + 4)) {
            pg8::Gemm g{HB, Wf2_t + (size_t)l * DM * DFF, M, DM, DFF}; pg8::StaticOrder S; S.init(M, DM, G, bx);
            pg8::EpiResF32 E{out, out + (size_t)M_P * DM, M_P, out, l + 1 < DEPTH ? XN : nullptr, l + 1 < DEPTH ? norm1_g + (l + 1) * DM : fin_g, SSQ + (size_t)(2 * l + 2) * M, SSQ + (size_t)(2 * l + 1) * M};
            pg8::gemm_phase<pg8::EpiResF32, pg8::StaticOrder, true, true>((LAS unsigned char*)lds, g, S, E);
        }
        SEAM(pb + 4);
    }
    if (IN(1 + 5 * DEPTH)) {
        LAUNDER();
        const float* sq = SSQ + (size_t)(2 * DEPTH) * M;
        for (int m = gw; m < M; m += NGW) { f32x4* xr = (f32x4*)(out + (size_t)m * DM) + lane; const f32x4* gr = (const f32x4*)fin_g + lane; const float rs = 1.f / sqrtf(sq[m] * (1.f / DM) + 1e-6f);
#pragma unroll
            for (int j = 0; j < 8; ++j) xr[64 * j] = xr[64 * j] * rs * gr[64 * j]; }
    }
#undef IN
#undef SEAM
}

extern "C" void kernel_launch(void* const* d_in, const int* in_sizes, int n_in, void* d_out, int out_size, void* d_ws, size_t ws_size, hipStream_t stream) {
    static int grid = 0;
    if (grid == 0) {
        if (n_in != 16 || in_sizes[0] != M_P * DM || in_sizes[1] != M_S * DM || out_size != M * DM || ws_size < WS_END) {
            fprintf(stderr, "kernel_launch: shape/workspace mismatch: n_in %d in0 %d in1 %d out %d ws %zu (need %zu)\n", n_in, n_in > 0 ? in_sizes[0] : -1, n_in > 1 ? in_sizes[1] : -1, out_size, ws_size, (size_t)WS_END);
            grid = -1; return; }
        int dev = 0, cus = 0, per_cu = 0;
        hipGetDevice(&dev); hipDeviceGetAttribute(&cus, hipDeviceAttributeMultiprocessorCount, dev);
        if (hipFuncSetAttribute((const void*)mega_fwd, hipFuncAttributeMaxDynamicSharedMemorySize, LDS_BYTES) != hipSuccess) { fprintf(stderr, "kernel_launch: hipFuncSetAttribute failed\n"); grid = -1; return; }
        if (hipOccupancyMaxActiveBlocksPerMultiprocessor(&per_cu, (const void*)mega_fwd, NWAVES * 64, LDS_BYTES) != hipSuccess || per_cu < 1) { fprintf(stderr, "kernel_launch: occupancy query gave %d\n", per_cu); per_cu = 1; }
        (void)hipGetLastError();
        grid = cus * per_cu;
    }
    if (grid < 0) return;
    Args a{};
    for (int i = 0; i < 16; ++i) a.in[i] = (const float*)d_in[i];
    a.out = (float*)d_out; a.ws = (unsigned char*)d_ws;
#if MK_MULTI
    for (int p = 0; p < N_PHASES; ++p) { a.ph_lo = p; a.ph_hi = p + 1; void* kargs[] = {&a};
        hipError_t e = hipLaunchCooperativeKernel((const void*)mega_fwd, dim3(grid), dim3(NWAVES * 64), kargs, LDS_BYTES, stream);
        if (e != hipSuccess) { fprintf(stderr, "kernel_launch: launch %d failed: %s (grid %d)\n", p, hipGetErrorString(e), grid); break; } }
#else
    a.ph_lo = 0; a.ph_hi = N_PHASES; void* kargs[] = {&a};
    hipError_t e = hipLaunchCooperativeKernel((const void*)mega_fwd, dim3(grid), dim3(NWAVES * 64), kargs, LDS_BYTES, stream);
    if (e != hipSuccess) fprintf(stderr, "kernel_launch: cooperative launch failed: %s (grid %d)\n", hipGetErrorString(e), grid);
#endif
}
```

```cpp
#include <hip/hip_runtime.h>
#include <hip/hip_bf16.h>
#include <hip/hip_cooperative_groups.h>
#include <cstdio>
#include <cstdint>
namespace cg = cooperative_groups;

#ifndef MK_MULTI
#define MK_MULTI 0
#endif


namespace pg8 {
#define PG8_LAS __attribute__((address_space(3)))
typedef unsigned short bf16_t;
typedef short bf16x8 __attribute__((ext_vector_type(8)));
typedef float f32x4 __attribute__((ext_vector_type(4)));
typedef unsigned u32x4 __attribute__((ext_vector_type(4)));
constexpr int BM = 256, BK = 64, HALF = 128, HTB = HALF * BK * 2  , STAGE_BYTES = 8 * HTB, NXCD = 8, WGM = 8;

__host__ __device__ __forceinline__ int lds_byte(int r, int c) { const int st = (r >> 4) * 2 + (c >> 5), rr = r & 15, cc = c & 31, ob = rr * 64 + cc * 2; return st * 1024 + (ob ^ (((ob >> 9) & 1) << 5)); }
__host__ __device__ __forceinline__ void stage_rc(int b, int& R, int& C) { const int st = b / 1024, sb = b % 1024, swz = sb ^ (((sb >> 9) & 1) << 5); R = (st >> 1) * 16 + swz / 64; C = (st & 1) * 32 + (swz % 64) / 2; }
__host__ __device__ __forceinline__ int perm32(int rho) { const int n = rho >> 4, i = rho & 15; return 8 * (i >> 2) + 4 * n + (i & 3); }

struct Unit { int pm, pn; };
struct Gemm { const bf16_t* A; const bf16_t* Bt; int M, N, K; };

struct StaticOrder {
    int nM, nN, nwg, G, c;
    __host__ __device__ void init(int M, int N, int G_, int c_) { nM = M / BM; nN = N / BM; nwg = nM * nN; G = G_; c = c_; }
    __host__ __device__ bool next(int i, Unit& u) const {
        const long L = (long)i * G + c; if (L >= nwg) return false;
        int wgid = (int)L; { const int q = nwg / NXCD, r = nwg % NXCD, xcd = wgid % NXCD, off = wgid / NXCD; wgid = (xcd < r ? xcd * (q + 1) : r * (q + 1) + (xcd - r) * q) + off; }
        const int nig = WGM * nN, gid = wgid / nig, fm = gid * WGM, gsz = (nM - fm) < WGM ? (nM - fm) : WGM;
        u.pm = fm + ((wgid % nig) % gsz); u.pn = (wgid % nig) / gsz; return true;
    }
    __device__ __forceinline__ void a_ready(const Unit&) const {}
    __device__ __forceinline__ void done(const Unit&) const {}
};

typedef unsigned u32x4 __attribute__((ext_vector_type(4)));
__device__ __forceinline__ unsigned cvt_pk_bf16(float lo, float hi) { unsigned r; asm volatile("v_cvt_pk_bf16_f32 %0, %1, %2" : "=v"(r) : "v"(lo), "v"(hi)); return r; }

template <int ACT  > struct EpiBf16 {
    static constexpr bool PERM = true, AFTER_DRAIN = false;
    bf16_t* O; int ldc; const float* ssq;
    __device__ __forceinline__ void operator()(const f32x4 (&acc)[2][2][4][2], const Unit& u, int wr, int wc, int fr, int fq) const {
        asm volatile("" : "+v"(fr), "+v"(fq));
        const int row0 = u.pm * BM + wr * 64 + fr; const int col0 = u.pn * BM + wc * 32 + 8 * fq;
#pragma unroll
        for (int ai = 0; ai < 2; ++ai)
#pragma unroll
            for (int m = 0; m < 4; ++m) { const int row = row0 + ai * HALF + m * 16; bf16_t* rowp = O + (size_t)row * ldc + col0;
                const float rs = ssq ? __builtin_amdgcn_rsqf(ssq[row] * (1.f / 2048.f) + 1e-6f) : 1.f;
#pragma unroll
                for (int bj = 0; bj < 2; ++bj) { f32x4 v0 = acc[ai][bj][m][0] * rs, v1 = acc[ai][bj][m][1] * rs;
                    if (ACT == 1) {
#pragma unroll
                        for (int e = 0; e < 4; ++e) { float a = fmaxf(v0[e], 0.f), b = fmaxf(v1[e], 0.f); v0[e] = a * a; v1[e] = b * b; } }
                    u32x4 w; w.x = cvt_pk_bf16(v0[0], v0[1]); w.y = cvt_pk_bf16(v0[2], v0[3]); w.z = cvt_pk_bf16(v1[0], v1[1]); w.w = cvt_pk_bf16(v1[2], v1[3]);
                    __builtin_nontemporal_store(w, (u32x4*)(rowp + bj * HALF)); } }
    }
};
struct EpiResF32 {
    static constexpr bool PERM = true, AFTER_DRAIN = false;
    const float* b0; const float* b1; int split; float* out; bf16_t* xn; const float* g; float* ssq; const float* rs2;
    __device__ __forceinline__ void operator()(const f32x4 (&acc)[2][2][4][2], const Unit& u, int wr, int wc, int fr, int fq) const {
        asm volatile("" : "+v"(fr), "+v"(fq));
        const int col0 = u.pn * BM + wc * 32 + 8 * fq;
        const int rt = u.pm * BM; const float* bb = (rt < split) ? b0 + (size_t)rt * 2048 : b1 + (size_t)(rt - split) * 2048; float* oo = out + (size_t)rt * 2048; bf16_t* xx = xn + (size_t)rt * 2048;
        float sacc[2][4];
        f32x4 gv[2][2];
#pragma unroll
        for (int bj = 0; bj < 2; ++bj) { gv[bj][0] = *(const f32x4*)(g + col0 + bj * HALF); gv[bj][1] = *(const f32x4*)(g + col0 + bj * HALF + 4); }
#pragma unroll
        for (int ai = 0; ai < 2; ++ai) {
            f32x4 pre[4][2][2]; float rq[4];
#pragma unroll
            for (int m = 0; m < 4; ++m) { const size_t off = (size_t)(ai * HALF + wr * 64 + m * 16 + fr) * 2048 + col0; rq[m] = rs2 ? rs2[rt + ai * HALF + wr * 64 + m * 16 + fr] : 0.f;
#pragma unroll
                for (int bj = 0; bj < 2; ++bj) { pre[m][bj][0] = *(const f32x4*)(bb + off + bj * HALF); pre[m][bj][1] = *(const f32x4*)(bb + off + bj * HALF + 4); } }
            asm volatile("" ::: "memory");
#pragma unroll
            for (int m = 0; m < 4; ++m) { const int rl = ai * HALF + wr * 64 + m * 16 + fr; const size_t off = (size_t)rl * 2048 + col0; float s = 0.f; const float sc = rs2 ? __builtin_amdgcn_rcpf(rq[m] * (1.f / 2048.f) + 1e-6f) : 1.f;
#pragma unroll
                for (int bj = 0; bj < 2; ++bj) {
                    const f32x4 v0 = pre[m][bj][0] + acc[ai][bj][m][0] * sc, v1 = pre[m][bj][1] + acc[ai][bj][m][1] * sc;
                    *(f32x4*)(oo + off + bj * HALF) = v0; *(f32x4*)(oo + off + bj * HALF + 4) = v1;
                    s += (v0[0] * v0[0] + v0[1] * v0[1]) + (v0[2] * v0[2] + v0[3] * v0[3]) + (v1[0] * v1[0] + v1[1] * v1[1]) + (v1[2] * v1[2] + v1[3] * v1[3]);
                    const f32x4 a = v0 * gv[bj][0], b = v1 * gv[bj][1];
                    u32x4 w; w.x = cvt_pk_bf16(a[0], a[1]); w.y = cvt_pk_bf16(a[2], a[3]); w.z = cvt_pk_bf16(b[0], b[1]); w.w = cvt_pk_bf16(b[2], b[3]);
                    if (xn) *(u32x4*)(xx + off + bj * HALF) = w; }
                s += __shfl_xor(s, 16); s += __shfl_xor(s, 32); sacc[ai][m] = s; }
            asm volatile("" ::: "memory");
        }
        if (fq == 0) {
#pragma unroll
            for (int ai = 0; ai < 2; ++ai)
#pragma unroll
                for (int m = 0; m < 4; ++m) atomicAdd(ssq + rt + ai * HALF + wr * 64 + m * 16 + fr, sacc[ai][m]); }
    }
};
template <class Epi, class Sched, bool ALIGN_EPI = false, bool SP2 = false>
__device__ __forceinline__ void gemm_phase(PG8_LAS unsigned char* lds, const Gemm g, const Sched& S, const Epi& E) {
    int tid_ = threadIdx.x; asm volatile("" : "+v"(tid_));
    const int tid = tid_, wid = __builtin_amdgcn_readfirstlane(tid >> 6), lane = tid & 63, wr = wid >> 2, wc = wid & 3, fr = lane & 15, fq = lane >> 4;
    const int K = g.K, nt = K / BK;
    unsigned voffA[2], voffB[2];
#pragma unroll
    for (int i = 0; i < 2; ++i) { int R, C; stage_rc(tid * 16 + i * 8192, R, C); const int Rb = Epi::PERM ? ((R & ~31) + perm32(R & 31)) : R;
        voffA[i] = (unsigned)(R * K + C) * 2u; voffB[i] = (unsigned)(Rb * K + C) * 2u; }
    const size_t kstep = (size_t)(BK * 2);
    const size_t hstep = (size_t)HALF * K * 2;
    const size_t tstep = 2 * hstep;
    const unsigned ldsw = (unsigned)wid * 1024u;
    const int aoff = lds_byte(wr * 64 + fr, fq * 8), boff = lds_byte(wc * 32 + fr, fq * 8);
#define PG8_SA(b, h) (((b) * 2 + (h)) * HTB)
#define PG8_SB(b, h) ((4 + (b) * 2 + (h)) * HTB)
#define PG8_STAGE(bufoff, gbase, voff) do { _Pragma("unroll") for (int _i = 0; _i < 2; ++_i) \
        __builtin_amdgcn_global_load_lds((const unsigned*)((const char*)(gbase) + (voff)[_i]), (PG8_LAS unsigned*)(lds + (bufoff) + ldsw + _i * 8192), 16, 0, 0); } while (0)
#define PG8_LDA(dst, b, h) do { _Pragma("unroll") for (int m = 0; m < 4; ++m) _Pragma("unroll") for (int k = 0; k < 2; ++k) dst[m][k] = *(const PG8_LAS bf16x8*)(lds + PG8_SA(b, h) + aoff + m * 2048 + k * 1024); } while (0)
#define PG8_LDB(dst, b, h) do { _Pragma("unroll") for (int n = 0; n < 2; ++n) _Pragma("unroll") for (int k = 0; k < 2; ++k) dst[n][k] = *(const PG8_LAS bf16x8*)(lds + PG8_SB(b, h) + boff + n * 2048 + k * 1024); } while (0)
#define PG8_MMA(ai, bj, At, Bt) do { __builtin_amdgcn_s_setprio(1); _Pragma("unroll") for (int m = 0; m < 4; ++m) _Pragma("unroll") for (int n = 0; n < 2; ++n) _Pragma("unroll") for (int k = 0; k < 2; ++k) \
        acc[ai][bj][m][n] = __builtin_amdgcn_mfma_f32_16x16x32_bf16(Bt[n][k], At[m][k], acc[ai][bj][m][n], 0, 0, 0); __builtin_amdgcn_s_setprio(0); } while (0)
#define PG8_WAIT_V(n) asm volatile("s_waitcnt vmcnt(" #n ")" ::: "memory")
#define PG8_WAIT_L(n) asm volatile("s_waitcnt lgkmcnt(" #n ")" ::: "memory")
#define PG8_BAR __builtin_amdgcn_s_barrier()
#define PG8_SCHED __builtin_amdgcn_sched_barrier(0)
    Unit cur, nxt; int ui = 0;
    if (!S.next(0, cur)) return;
    f32x4 acc[2][2][4][2];
#pragma unroll
    for (int a = 0; a < 2; ++a)
#pragma unroll
        for (int b = 0; b < 2; ++b)
#pragma unroll
            for (int m = 0; m < 4; ++m)
#pragma unroll
                for (int n = 0; n < 2; ++n) acc[a][b][m][n] = (f32x4){0.f, 0.f, 0.f, 0.f};
    bf16x8 At[4][2], B0[2][2], B1[2][2];
    const char* cA = (const char*)g.A + (size_t)cur.pm * tstep; const char* cB = (const char*)g.Bt + (size_t)cur.pn * tstep;
    S.a_ready(cur);
    if constexpr (SP2) {
        PG8_STAGE(PG8_SB(0, 0), cB, voffB); PG8_STAGE(PG8_SB(0, 1), cB + hstep, voffB); PG8_STAGE(PG8_SA(0, 0), cA, voffA); PG8_STAGE(PG8_SA(0, 1), cA + hstep, voffA);
        if (wr == 1) PG8_BAR;
        PG8_WAIT_V(2); PG8_BAR;
        PG8_STAGE(PG8_SB(1, 0), cB + kstep, voffB); PG8_STAGE(PG8_SA(1, 0), cA + kstep, voffA); PG8_STAGE(PG8_SB(1, 1), cB + hstep + kstep, voffB);
        PG8_WAIT_V(6); PG8_BAR;
    } else {
        PG8_STAGE(PG8_SB(0, 0), cB, voffB); PG8_STAGE(PG8_SA(0, 0), cA, voffA); PG8_STAGE(PG8_SB(0, 1), cB + hstep, voffB); PG8_STAGE(PG8_SA(0, 1), cA + hstep, voffA);
        if (wr == 1) PG8_BAR;
        PG8_WAIT_V(4); PG8_BAR;
        PG8_STAGE(PG8_SB(1, 0), cB + kstep, voffB); PG8_STAGE(PG8_SA(1, 0), cA + kstep, voffA); PG8_STAGE(PG8_SB(1, 1), cB + hstep + kstep, voffB);
        PG8_WAIT_V(6); PG8_BAR;
    }
    for (;;) {
        const bool has_next = S.next(ui + 1, nxt);
        const char* nA = has_next ? (const char*)g.A + (size_t)nxt.pm * tstep : cA; const char* nB = has_next ? (const char*)g.Bt + (size_t)nxt.pn * tstep : cB;
        for (int t = 0; t < nt; t += 2) {
            const bool last = (t == nt - 2);
            const char* a1 = cA + (size_t)(t + 1) * kstep;
            const char* a2 = last ? nA : cA + (size_t)(t + 2) * kstep; const char* b2 = last ? nB : cB + (size_t)(t + 2) * kstep;
            const char* a3 = a2 + kstep; const char* b3 = b2 + kstep;
            if (last && has_next) S.a_ready(nxt);
            if constexpr (SP2) {
            PG8_LDB(B0, 0, 0); PG8_LDB(B1, 0, 1); PG8_SCHED; PG8_LDA(At, 0, 0); PG8_STAGE(PG8_SA(1, 1), a1 + hstep, voffA);
            PG8_WAIT_V(8); PG8_WAIT_L(0); PG8_BAR; PG8_MMA(0, 0, At, B0); PG8_MMA(0, 1, At, B1); PG8_BAR; PG8_SCHED;
            PG8_LDA(At, 0, 1); PG8_STAGE(PG8_SB(0, 0), b2, voffB); PG8_STAGE(PG8_SB(0, 1), b2 + hstep, voffB); PG8_STAGE(PG8_SA(0, 0), a2, voffA);
            PG8_WAIT_V(8); PG8_WAIT_L(0); PG8_BAR; PG8_MMA(1, 0, At, B0); PG8_MMA(1, 1, At, B1); PG8_BAR; PG8_SCHED;
            PG8_LDB(B0, 1, 0); PG8_LDB(B1, 1, 1); PG8_SCHED; PG8_LDA(At, 1, 0); PG8_STAGE(PG8_SA(0, 1), a2 + hstep, voffA);
            PG8_WAIT_V(8); PG8_WAIT_L(0); PG8_BAR; PG8_MMA(0, 0, At, B0); PG8_MMA(0, 1, At, B1); PG8_BAR; PG8_SCHED;
            PG8_LDA(At, 1, 1); PG8_STAGE(PG8_SB(1, 0), b3, voffB); PG8_STAGE(PG8_SB(1, 1), b3 + hstep, voffB); PG8_STAGE(PG8_SA(1, 0), a3, voffA);
            PG8_WAIT_V(8); PG8_WAIT_L(0); PG8_BAR; PG8_MMA(1, 0, At, B0); PG8_MMA(1, 1, At, B1); PG8_BAR; PG8_SCHED;
            } else {
            PG8_LDB(B0, 0, 0); PG8_SCHED; PG8_LDA(At, 0, 0); PG8_STAGE(PG8_SA(1, 1), a1 + hstep, voffA);
            PG8_WAIT_L(8); PG8_BAR; PG8_WAIT_L(0); PG8_MMA(0, 0, At, B0); PG8_BAR; PG8_SCHED;
            PG8_LDB(B1, 0, 1); PG8_STAGE(PG8_SB(0, 0), b2, voffB);
            PG8_BAR; PG8_WAIT_L(0); PG8_MMA(0, 1, At, B1); PG8_BAR;
            PG8_LDA(At, 0, 1); PG8_STAGE(PG8_SA(0, 0), a2, voffA);
            PG8_BAR; PG8_WAIT_L(0); PG8_MMA(1, 0, At, B0); PG8_BAR; PG8_SCHED;
            PG8_STAGE(PG8_SB(0, 1), b2 + hstep, voffB);
            PG8_WAIT_V(6); PG8_BAR; PG8_MMA(1, 1, At, B1); PG8_BAR;
            PG8_LDB(B0, 1, 0); PG8_SCHED; PG8_LDA(At, 1, 0); PG8_STAGE(PG8_SA(0, 1), a2 + hstep, voffA);
            PG8_WAIT_L(8); PG8_BAR; PG8_WAIT_L(0); PG8_MMA(0, 0, At, B0); PG8_BAR; PG8_SCHED;
            PG8_LDB(B1, 1, 1); PG8_STAGE(PG8_SB(1, 0), b3, voffB);
            PG8_BAR; PG8_WAIT_L(0); PG8_MMA(0, 1, At, B1); PG8_BAR;
            PG8_LDA(At, 1, 1); PG8_STAGE(PG8_SA(1, 0), a3, voffA);
            PG8_BAR; PG8_WAIT_L(0); PG8_MMA(1, 0, At, B0); PG8_BAR; PG8_SCHED;
            PG8_STAGE(PG8_SB(1, 1), b3 + hstep, voffB);
            PG8_WAIT_V(6); PG8_BAR; PG8_MMA(1, 1, At, B1); PG8_BAR;
            }
        }
        if constexpr (ALIGN_EPI) { if (wr == 0) PG8_BAR; }
        if constexpr (!Epi::AFTER_DRAIN) { E(acc, cur, wr, wc, fr, fq); S.done(cur); }
        if (!has_next) break;
#pragma unroll
        for (int a = 0; a < 2; ++a)
#pragma unroll
            for (int b = 0; b < 2; ++b)
#pragma unroll
                for (int m = 0; m < 4; ++m)
#pragma unroll
                    for (int n = 0; n < 2; ++n) acc[a][b][m][n] = (f32x4){0.f, 0.f, 0.f, 0.f};
        cur = nxt; cA = nA; cB = nB; ++ui;
        if constexpr (ALIGN_EPI) { if (wr == 1) PG8_BAR; }
    }
    PG8_WAIT_V(0);
    if constexpr (!ALIGN_EPI) { if (wr == 0) PG8_BAR; }
    PG8_BAR;
    if constexpr (Epi::AFTER_DRAIN) { E.fused(acc, cur, wr, wc, fr, fq, lds, wid, lane); S.done(cur); }
#undef PG8_SA
#undef PG8_SB
#undef PG8_STAGE
#undef PG8_LDA
#undef PG8_LDB
#undef PG8_MMA
#undef PG8_WAIT_V
#undef PG8_WAIT_L
#undef PG8_BAR
#undef PG8_SCHED
}
}
namespace att {
using bf16 = unsigned short;
using bf16x8 = __attribute__((ext_vector_type(8))) short;
using s16x4  = __attribute__((ext_vector_type(4))) short;
using f32x16 = __attribute__((ext_vector_type(16))) float;
using u32x4  = __attribute__((ext_vector_type(4))) unsigned;
constexpr int KVBLK = 64, LDP = 4608, LDO = 2048;
constexpr int SHM_V = 16384, SHM_K = 16384;
constexpr int SLOT = SHM_V + SHM_K, NSLOT = 3;
constexpr int OFF_V = 0, OFF_K = SHM_V, OFF_WS = NSLOT * SLOT, OFF_TAB = OFF_WS + 8 * 64 * 4, ATT_LDS = OFF_TAB + 272 * 4;
constexpr float LOG2E = 1.4426950408889634f;
constexpr float THR = 8.f;
constexpr float NEGB = -1e30f;
#define KSWZ(row, colB) ((row) * 256 + ((colB) ^ (((row) & 7) << 4)))
#define SBAR() __builtin_amdgcn_sched_barrier(0)
__device__ __forceinline__ int crow(int r, int hi) { return (r & 3) + 8 * (r >> 2) + 4 * hi; }
__device__ __forceinline__ unsigned cvtpk(float lo, float hi) { unsigned r; asm volatile("v_cvt_pk_bf16_f32 %0, %1, %2" : "=v"(r) : "v"(lo), "v"(hi)); return r; }
__device__ __forceinline__ bf16x8 ld8(const bf16* p) { return *reinterpret_cast<const bf16x8*>(p); }

__device__ __forceinline__ float max3f(float a, float b, float c) { float r; asm("v_max3_f32 %0, %1, %2, %3" : "=v"(r) : "v"(a), "v"(b), "v"(c)); return r; }
__device__ __forceinline__ int t5_bucket(int rel) {
  const int n = rel < 0 ? -rel : rel; int b;
  if (n < 8) b = n; else { int l = (31 - __builtin_clz((unsigned)(n * n))) - 6; b = 8 + l; if (b > 15) b = 15; }
  return (rel > 0 ? 16 : 0) + b;
}

__device__ __forceinline__ void partialSM(f32x16& p0, f32x16& p1, float& m_reg, float& alpha, float Ce, float be) {
  float pmax = max3f(p0[0], p0[1], p1[0]), pmb = max3f(p0[2], p0[3], p1[1]);
  pmax = max3f(pmax, p1[2], p1[3]);
#pragma unroll
  for (int r = 4; r < 16; r += 4) { pmax = max3f(pmax, p0[r], p0[r + 1]); pmb = max3f(pmb, p0[r + 2], p0[r + 3]); pmax = max3f(pmax, p1[r], p1[r + 1]); pmb = max3f(pmb, p1[r + 2], p1[r + 3]); }
  pmax = max3f(pmax, pmb, pmb);
  { auto rr = __builtin_amdgcn_permlane32_swap(__float_as_uint(pmax), __float_as_uint(pmax), false, false);
    pmax = fmaxf(__uint_as_float(rr[0]), __uint_as_float(rr[1])); }
  pmax = fmaf(pmax, Ce, be);
  float mn;
  if (__builtin_expect(__all(pmax - m_reg <= THR), 1)) { mn = m_reg; alpha = 1.f; }
  else { mn = fmaxf(m_reg, pmax); alpha = __builtin_amdgcn_exp2f(m_reg - mn); m_reg = mn; }
  const float off = be - mn;
#pragma unroll
  for (int r = 0; r < 16; ++r) p0[r] = fmaf(p0[r], Ce, off);
#pragma unroll
  for (int r = 0; r < 16; ++r) p1[r] = fmaf(p1[r], Ce, off);
#pragma unroll
  for (int r = 0; r < 16; ++r) p0[r] = __builtin_amdgcn_exp2f(p0[r]);
}
__device__ __forceinline__ void finishSM(f32x16& p0, f32x16& p1, float alpha, float& l_reg, bf16x8& pa0, bf16x8& pa1, bf16x8& pa2, bf16x8& pa3) {
#pragma unroll
  for (int r = 0; r < 16; ++r) p1[r] = __builtin_amdgcn_exp2f(p1[r]);
  float ps = 0;
#pragma unroll
  for (int r = 0; r < 16; ++r) ps += p0[r];
#pragma unroll
  for (int r = 0; r < 16; ++r) ps += p1[r];
  { auto rr = __builtin_amdgcn_permlane32_swap(__float_as_uint(ps), __float_as_uint(ps), false, false);
    ps = __uint_as_float(rr[0]) + __uint_as_float(rr[1]); }
  l_reg = l_reg * alpha + ps;
#define PK4(P, BASE, OUT) do { unsigned a0 = cvtpk(P[BASE + 0], P[BASE + 1]), a1 = cvtpk(P[BASE + 2], P[BASE + 3]);   \
    unsigned b0 = cvtpk(P[BASE + 4], P[BASE + 5]), b1 = cvtpk(P[BASE + 6], P[BASE + 7]);                              \
    auto r0 = __builtin_amdgcn_permlane32_swap(a0, b0, false, false); auto r1 = __builtin_amdgcn_permlane32_swap(a1, b1, false, false); \
    u32x4 w = {r0[0], r1[0], r0[1], r1[1]}; OUT = *reinterpret_cast<bf16x8*>(&w); } while (0)
  PK4(p0, 0, pa0); PK4(p0, 8, pa1); PK4(p1, 0, pa2); PK4(p1, 8, pa3);
#undef PK4
}
__device__ __forceinline__ bf16x8 scale_bf16x8(bf16x8 v, float c) {
  u32x4 w = *reinterpret_cast<u32x4*>(&v), o;
#pragma unroll
  for (int i = 0; i < 4; ++i) { const float lo = __uint_as_float(w[i] << 16), hh = __uint_as_float(w[i] & 0xffff0000u); o[i] = cvtpk(lo * c, hh * c); }
  return *reinterpret_cast<bf16x8*>(&o);
}
template <int ND0> __device__ __forceinline__ void qkt(f32x16& p0, f32x16& p1, const char* Ks, const bf16x8* qr, int r32, int hi, int cboff, const f32x16& ci) {
#pragma unroll
  for (int d0 = 0; d0 < ND0; ++d0) { int cb = cboff + (d0 * 16 + hi * 8) * 2;
    bf16x8 b0 = *reinterpret_cast<const bf16x8*>(Ks + KSWZ(r32, cb));
    bf16x8 b1 = *reinterpret_cast<const bf16x8*>(Ks + KSWZ(32 + r32, cb));
    if (d0 == 0) { p0 = __builtin_amdgcn_mfma_f32_32x32x16_bf16(b0, qr[0], ci, 0, 0, 0); p1 = __builtin_amdgcn_mfma_f32_32x32x16_bf16(b1, qr[0], ci, 0, 0, 0); }
    else { p0 = __builtin_amdgcn_mfma_f32_32x32x16_bf16(b0, qr[d0], p0, 0, 0, 0); p1 = __builtin_amdgcn_mfma_f32_32x32x16_bf16(b1, qr[d0], p1, 0, 0, 0); } }
}
template <bool FIRST> __device__ __forceinline__ void partialSM2(f32x16& p0, f32x16& p1, float& m_ref, f32x16& negm, float& alpha) {
  float pmax = max3f(p0[0], p0[1], p1[0]), pmb = max3f(p0[2], p0[3], p1[1]);
  pmax = max3f(pmax, p1[2], p1[3]);
#pragma unroll
  for (int r = 4; r < 16; r += 4) { pmax = max3f(pmax, p0[r], p0[r + 1]); pmb = max3f(pmb, p0[r + 2], p0[r + 3]); pmax = max3f(pmax, p1[r], p1[r + 1]); pmb = max3f(pmb, p1[r + 2], p1[r + 3]); }
  pmax = max3f(pmax, pmb, pmb);
  { auto rr = __builtin_amdgcn_permlane32_swap(__float_as_uint(pmax), __float_as_uint(pmax), false, false);
    pmax = fmaxf(__uint_as_float(rr[0]), __uint_as_float(rr[1])); }
  alpha = 1.f;
  if (FIRST || !__builtin_expect(__all(pmax <= THR), 1)) {
    const float dl = FIRST ? pmax : fmaxf(pmax, 0.f); m_ref += dl; if (!FIRST) alpha = __builtin_amdgcn_exp2f(-dl);
#pragma unroll
    for (int r = 0; r < 16; ++r) { p0[r] -= dl; p1[r] -= dl; negm[r] -= dl; }
  }
#pragma unroll
  for (int r = 0; r < 16; ++r) p0[r] = __builtin_amdgcn_exp2f(p0[r]);
}
__device__ __forceinline__ int v_st(int k, int c) { const int kk = (k & ~0xC) | ((k & 4) << 1) | ((k & 8) >> 1); return ((kk >> 3) * 4 + (c >> 5)) * 512 + ((kk & 7) * 32 + (c & 31)) * 2; }
__device__ __forceinline__ int v_rd_base(int lane) { return ((lane & 3) << 3) | (((lane >> 2) & 3) << 6) | (((lane >> 4) & 1) << 5) | (((lane >> 5) & 1) << 8); }
constexpr int v_rd_off(int d0, int ks, int half) { return d0 * 512 + ks * 4096 + half * 2048; }
template <int OFF> __device__ __forceinline__ s16x4 tr_read(int vb) {
  s16x4 r; asm volatile("ds_read_b64_tr_b16 %0, %1 offset:%2" : "=&v"(r) : "v"(vb), "i"(OFF) : "memory"); return r;
}
#define VRD8(D0, L0, H0, L1, H1, L2, H2, L3, H3) do { L0 = tr_read<v_rd_off(D0, 0, 0)>(vb); H0 = tr_read<v_rd_off(D0, 0, 1)>(vb); L1 = tr_read<v_rd_off(D0, 1, 0)>(vb); H1 = tr_read<v_rd_off(D0, 1, 1)>(vb); \
    L2 = tr_read<v_rd_off(D0, 2, 0)>(vb); H2 = tr_read<v_rd_off(D0, 2, 1)>(vb); L3 = tr_read<v_rd_off(D0, 3, 0)>(vb); H3 = tr_read<v_rd_off(D0, 3, 1)>(vb); } while (0)
#define PK(L, H) (bf16x8){L[0], L[1], L[2], L[3], H[0], H[1], H[2], H[3]}
#define MMA4(OD, L0, H0, L1, H1, L2, H2, L3, H3) do { OD = __builtin_amdgcn_mfma_f32_32x32x16_bf16(pa0, PK(L0, H0), OD, 0, 0, 0); OD = __builtin_amdgcn_mfma_f32_32x32x16_bf16(pa1, PK(L1, H1), OD, 0, 0, 0); \
    OD = __builtin_amdgcn_mfma_f32_32x32x16_bf16(pa2, PK(L2, H2), OD, 0, 0, 0); OD = __builtin_amdgcn_mfma_f32_32x32x16_bf16(pa3, PK(L3, H3), OD, 0, 0, 0); } while (0)
__device__ __forceinline__ void pv_d0(f32x16* o, int vb, bf16x8 pa0, bf16x8 pa1, bf16x8 pa2, bf16x8 pa3) {
  s16x4 a0, a1, a2, a3, a4, a5, a6, a7, b0, b1, b2, b3, b4, b5, b6, b7;
  VRD8(0, a0, a1, a2, a3, a4, a5, a6, a7);
  VRD8(1, b0, b1, b2, b3, b4, b5, b6, b7);
  asm volatile("s_waitcnt lgkmcnt(8)" ::: "memory"); SBAR();
  MMA4(o[0], a0, a1, a2, a3, a4, a5, a6, a7); SBAR();
  VRD8(2, a0, a1, a2, a3, a4, a5, a6, a7);
  asm volatile("s_waitcnt lgkmcnt(8)" ::: "memory"); SBAR();
  MMA4(o[1], b0, b1, b2, b3, b4, b5, b6, b7); SBAR();
  VRD8(3, b0, b1, b2, b3, b4, b5, b6, b7);
  asm volatile("s_waitcnt lgkmcnt(8)" ::: "memory"); SBAR();
  MMA4(o[2], a0, a1, a2, a3, a4, a5, a6, a7); SBAR();
  asm volatile("s_waitcnt lgkmcnt(0)" ::: "memory"); SBAR();
  MMA4(o[3], b0, b1, b2, b3, b4, b5, b6, b7);
}
__device__ __forceinline__ void pv_partial(f32x16* o, int vb, bf16x8 pa0, bf16x8 pa1, bf16x8 pa2, bf16x8 pa3, f32x16& p0, f32x16& p1, float& m_ref, f32x16& negm, float& alpha) {
  s16x4 a0, a1, a2, a3, a4, a5, a6, a7, b0, b1, b2, b3, b4, b5, b6, b7;
  VRD8(0, a0, a1, a2, a3, a4, a5, a6, a7);
  VRD8(1, b0, b1, b2, b3, b4, b5, b6, b7);
  asm volatile("s_waitcnt lgkmcnt(8)" ::: "memory"); SBAR();
  MMA4(o[0], a0, a1, a2, a3, a4, a5, a6, a7);
  float pmax = max3f(p0[0], p0[1], p1[0]), pmb = max3f(p0[2], p0[3], p1[1]);
  pmax = max3f(pmax, p1[2], p1[3]);
#pragma unroll
  for (int r = 4; r < 16; r += 4) { pmax = max3f(pmax, p0[r], p0[r + 1]); pmb = max3f(pmb, p0[r + 2], p0[r + 3]); pmax = max3f(pmax, p1[r], p1[r + 1]); pmb = max3f(pmb, p1[r + 2], p1[r + 3]); }
  pmax = max3f(pmax, pmb, pmb);
  SBAR();
  VRD8(2, a0, a1, a2, a3, a4, a5, a6, a7);
  asm volatile("s_waitcnt lgkmcnt(8)" ::: "memory"); SBAR();
  MMA4(o[1], b0, b1, b2, b3, b4, b5, b6, b7);
  { auto rr = __builtin_amdgcn_permlane32_swap(__float_as_uint(pmax), __float_as_uint(pmax), false, false);
    pmax = fmaxf(__uint_as_float(rr[0]), __uint_as_float(rr[1])); }
  alpha = 1.f;
  if (!__builtin_expect(__all(pmax <= THR), 1)) {
    const float dl = fmaxf(pmax, 0.f); m_ref += dl; alpha = __builtin_amdgcn_exp2f(-dl);
#pragma unroll
    for (int r = 0; r < 16; ++r) { p0[r] -= dl; p1[r] -= dl; negm[r] -= dl; }
  }
  SBAR();
  VRD8(3, b0, b1, b2, b3, b4, b5, b6, b7);
  asm volatile("s_waitcnt lgkmcnt(8)" ::: "memory"); SBAR();
  MMA4(o[2], a0, a1, a2, a3, a4, a5, a6, a7);
#pragma unroll
  for (int r = 0; r < 8; ++r) p0[r] = __builtin_amdgcn_exp2f(p0[r]);
  SBAR();
  asm volatile("s_waitcnt lgkmcnt(0)" ::: "memory"); SBAR();
  MMA4(o[3], b0, b1, b2, b3, b4, b5, b6, b7);
#pragma unroll
  for (int r = 8; r < 16; ++r) p0[r] = __builtin_amdgcn_exp2f(p0[r]);
}
#undef VRD8
#undef PK
#undef MMA4

template <int MODE, int ORD>
__device__ __forceinline__ void attn_unit(const bf16* __restrict__ Qb, const bf16* __restrict__ Kh, const bf16* __restrict__ Vh, bf16* __restrict__ Ob,
                                          int qpos0, int kbeg, int NT, const float* __restrict__ tabsrc, float sinkv, float lam, float oscale,
                                          const float* __restrict__ subg, char* lds) {
  constexpr int ND0 = MODE == 0 ? 4 : 8;
  const float C = (MODE == 0 ? 0.125f : 0.08838834764831845f) * LOG2E;
  int tid_ = threadIdx.x; asm volatile("" : "+v"(tid_));
  const int tid = tid_, wid = __builtin_amdgcn_readfirstlane(tid >> 6), lane = tid & 63; int r32 = lane & 31, hi = lane >> 5;
  const int wq = MODE == 0 ? (wid & 3) : wid, cst = MODE == 0 ? (wid >> 2) : 0;
  char* V_lds = lds + OFF_V; char* K_lds = lds + OFF_K;
  float* wsf = (float*)(lds + OFF_WS) + wid * 64; float* li_l = wsf; float* al_l = wsf + 32;
  float* tab = (float*)(lds + OFF_TAB);
  __syncthreads();
  if (wid >= 4) __builtin_amdgcn_s_setprio(1);
  if (tid < 257) tab[tid] = tabsrc[t5_bucket(tid - 128) * 16] * LOG2E;
  float m_reg = MODE == 0 ? 0.f : sinkv * LOG2E, l_reg = MODE == 0 ? 0.f : 1.f;
  f32x16 o[4] = {}; bf16x8 qr[ND0];
  const bf16* Qw = Qb + (long)(wq * 32 + r32) * LDP + cst * 64 + hi * 8;
#pragma unroll
  for (int d0 = 0; d0 < ND0; ++d0) qr[d0] = scale_bf16x8(ld8(Qw + d0 * 16), C);
  const int qpos = qpos0 + wq * 32 + r32;
  const int qw0 = qpos0 + wq * 32;
  const int cboff = cst * 128;
  int sr = tid >> 4, sc = (tid & 15) * 8, vst0 = v_st(sr, sc), vst1 = v_st(32 + sr, sc);
  int vb0 = (int)(uintptr_t)V_lds + v_rd_base(lane);
  const bf16* Kg = Kh + (long)kbeg * LDP; const bf16* Vg = Vh + (long)kbeg * LDP;
  struct { bf16x8 vs0, vs1, ks0, ks1; } sr_[1];
#define SLOAD(i, k0) do { sr_[i].vs0 = ld8(&Vg[(long)((k0) + sr) * LDP + sc]); sr_[i].vs1 = ld8(&Vg[(long)((k0) + 32 + sr) * LDP + sc]); \
    sr_[i].ks0 = ld8(&Kg[(long)((k0) + sr) * LDP + sc]); sr_[i].ks1 = ld8(&Kg[(long)((k0) + 32 + sr) * LDP + sc]); } while (0)
#define SWRITE(off, i) do { *(bf16x8*)(V_lds + (off) + vst0) = sr_[i].vs0;          \
    *(bf16x8*)(V_lds + (off) + vst1) = sr_[i].vs1; int kc = sc * 2;               \
    *(bf16x8*)(K_lds + (off) + KSWZ(sr, kc)) = sr_[i].ks0;                       \
    *(bf16x8*)(K_lds + (off) + KSWZ(32 + sr, kc)) = sr_[i].ks1; } while (0)
#define SWAIT() asm volatile("s_waitcnt vmcnt(0)" ::: "memory")
#define RESC(a) do { if (__any((a) < 1.f)) { if (hi == 0) al_l[r32] = (a); asm volatile("s_waitcnt lgkmcnt(0)" ::: "memory"); \
    _Pragma("unroll") for (int d = 0; d < 4; ++d) _Pragma("unroll") for (int r = 0; r < 16; ++r) o[d][r] *= al_l[crow(r, hi)]; } } while (0)
  float bL, bR, be_cur = 0.f; f32x16 negm;
#pragma unroll
  for (int r = 0; r < 16; ++r) negm[r] = -m_reg;
#define TCLS(t) const int k0_ = kbeg + (t) * KVBLK; const int rmax_ = k0_ + 63 - qw0, rmin_ = k0_ - qw0 - 31; const bool near_ = (MODE == 1) || (rmax_ > -128 && rmin_ < 128)
#define SETBE(t) do { TCLS(t); const float bt_ = near_ ? 0.f : ((rmax_ <= -128) ? bL : bR); \
    if (bt_ != be_cur) { const float d_ = bt_ - be_cur; _Pragma("unroll") for (int r = 0; r < 16; ++r) negm[r] += d_; be_cur = bt_; } } while (0)
#define BIAS(P0, P1, t) do { TCLS(t); (void)rmin_; (void)rmax_; \
    if (near_) { asm volatile("" ::: "memory");     \
      const int base_ = k0_ - qpos + 128 + 4 * hi; \
      _Pragma("unroll") for (int r = 0; r < 16; ++r) { const int i0 = base_ + (r & 3) + 8 * (r >> 2), i1 = i0 + 32; \
        const int c0 = i0 < 0 ? 0 : (i0 > 256 ? 256 : i0), c1 = i1 < 0 ? 0 : (i1 > 256 ? 256 : i1); \
        const float t0 = P0[r] + tab[c0], t1 = P1[r] + tab[c1]; \
        if (MODE == 1) { P0[r] = (i0 == c0) ? t0 : NEGB; P1[r] = (i1 == c1) ? t1 : NEGB; } else { P0[r] = t0; P1[r] = t1; } } \
      asm volatile("" ::: "memory"); } } while (0)
  f32x16 pA0, pA1, pB0, pB1; float alA, alB; bf16x8 pa0, pa1, pa2, pa3;
  constexpr int SE = 0, SO = 0;
  SLOAD(SE, 0); asm volatile("s_waitcnt vmcnt(0)" ::: "memory"); SWRITE(0, SE); __syncthreads();
  bL = tab[0]; bR = tab[256];
  SETBE(0); qkt<ND0>(pA0, pA1, K_lds, qr, r32, hi, cboff, negm); BIAS(pA0, pA1, 0); partialSM2<MODE == 0>(pA0, pA1, m_reg, negm, alA);
  SLOAD(SO, KVBLK);
  SWAIT(); SWRITE(SLOT, SO); __syncthreads();
  int op = 0, oc = SLOT, on = 2 * SLOT;
#define ROT() do { const int t_ = op; op = oc; oc = on; on = t_; } while (0)
#define TILE_STEP1(PN0, PN1, ALN, PO0, PO1, ALO, TN, LOADS) do { \
      SBAR(); finishSM(PO0, PO1, ALO, l_reg, pa0, pa1, pa2, pa3); SBAR(); LOADS; SETBE(TN); SBAR(); qkt<ND0>(PN0, PN1, K_lds + oc, qr, r32, hi, cboff, negm); SBAR(); \
      BIAS(PN0, PN1, TN); partialSM2<false>(PN0, PN1, m_reg, negm, ALN); SBAR(); pv_d0(o, vb0 + op, pa0, pa1, pa2, pa3); } while (0)
#define MAIN_LOOP(TS) do { \
  for (int j = 1; j + 1 < NT; j += 2) { \
    TS(pB0, pB1, alB, pA0, pA1, alA, j, SLOAD(SO, (j + 1) * KVBLK)); \
    SWAIT(); SWRITE(on, SE); RESC(alB); __syncthreads(); ROT(); \
    TS(pA0, pA1, alA, pB0, pB1, alB, j + 1, SLOAD(SE, (j + 2) * KVBLK)); \
    SWAIT(); SWRITE(on, SO); RESC(alA); __syncthreads(); ROT(); \
  } \
  TS(pB0, pB1, alB, pA0, pA1, alA, NT - 1, (void)0); } while (0)
#define TILE_STEPX(PN0, PN1, ALN, PO0, PO1, ALO, TN, LOADS) do { \
      SBAR(); LOADS; SETBE(TN); SBAR(); qkt<ND0>(PN0, PN1, K_lds + oc, qr, r32, hi, cboff, negm); finishSM(PO0, PO1, ALO, l_reg, pa0, pa1, pa2, pa3); SBAR(); \
      BIAS(PN0, PN1, TN); SBAR(); pv_partial(o, vb0 + op, pa0, pa1, pa2, pa3, PN0, PN1, m_reg, negm, ALN); } while (0)
  MAIN_LOOP(TILE_STEPX);
#undef MAIN_LOOP
#undef TILE_STEPX
#undef TILE_STEP1
#undef SETBE
#undef TCLS
  RESC(alB);
  finishSM(pB0, pB1, alB, l_reg, pa0, pa1, pa2, pa3); SBAR();
  pv_d0(o, vb0 + oc, pa0, pa1, pa2, pa3);
#undef ROT
  if (hi == 0) li_l[r32] = l_reg; asm volatile("s_waitcnt lgkmcnt(0)" ::: "memory");
  float rli[16];
#pragma unroll
  for (int r = 0; r < 16; ++r) rli[r] = __builtin_amdgcn_rcpf(li_l[crow(r, hi)]);
  if (MODE == 1) {
    bf16* Ow = Ob + (long)(wq * 32) * LDO;
#pragma unroll
    for (int r = 0; r < 16; ++r) { const int orow = crow(r, hi);
#pragma unroll
      for (int d0 = 0; d0 < 4; ++d0) { __hip_bfloat16 bv = __float2bfloat16(o[d0][r] * rli[r]); Ow[(long)orow * LDO + d0 * 32 + r32] = *reinterpret_cast<bf16*>(&bv); } }
  } else {
    __syncthreads();
    float* X = (float*)lds + wq * 4096;
    if (cst == 1) {
#pragma unroll
      for (int r = 0; r < 16; ++r) { const int orow = crow(r, hi);
#pragma unroll
        for (int d0 = 0; d0 < 4; ++d0) X[orow * 128 + d0 * 32 + r32] = o[d0][r] * rli[r]; }
    }
    __syncthreads();
    if (cst == 0) {
      float ssq[16];
#pragma unroll
      for (int r = 0; r < 16; ++r) { const int orow = crow(r, hi); float s = 0.f;
#pragma unroll
        for (int d0 = 0; d0 < 4; ++d0) { const float v = o[d0][r] * rli[r] - lam * X[orow * 128 + d0 * 32 + r32]; o[d0][r] = v; s = fmaf(v, v, s); }
        ssq[r] = s; }
#pragma unroll
      for (int r = 0; r < 16; ++r) {
#pragma unroll
        for (int off = 1; off < 32; off <<= 1) ssq[r] += __shfl_xor(ssq[r], off);
      }
      float gg[4];
#pragma unroll
      for (int d0 = 0; d0 < 4; ++d0) gg[d0] = subg[d0 * 32 + r32] * oscale;
      bf16* Ow = Ob + (long)(wq * 32) * LDO;
#pragma unroll
      for (int r = 0; r < 16; ++r) { const int orow = crow(r, hi); const float rs = __builtin_amdgcn_rsqf(ssq[r] * (1.f / 128.f) + 1e-6f);
#pragma unroll
        for (int d0 = 0; d0 < 4; ++d0) { __hip_bfloat16 bv = __float2bfloat16(o[d0][r] * rs * gg[d0]); Ow[(long)orow * LDO + d0 * 32 + r32] = *reinterpret_cast<bf16*>(&bv); } }
    }
  }
  __builtin_amdgcn_s_setprio(0);
#undef SLOAD
#undef SWRITE
#undef SWAIT
#undef RESC
#undef BIAS
}
#undef SBAR
}

#define LAS __attribute__((address_space(3)))
typedef unsigned short bf16;
typedef unsigned v4u __attribute__((ext_vector_type(4)));
typedef float f32x4 __attribute__((ext_vector_type(4)));
constexpr int NWAVES = 8;
constexpr int DM = 2048, SEQ_P = 8192, NB_P = 4, SEQ_S = 4096, NB_S = 2, DEPTH = 2, DFF = 8192, INW = 4608;
constexpr int M_P = NB_P * SEQ_P, M_S = NB_S * SEQ_S, M = M_P + M_S;
constexpr size_t MiB = 1u << 20;
constexpr size_t WS_WIN = 1 * MiB;
constexpr size_t WS_WOUT = WS_WIN + (size_t)DEPTH * INW * DM * 2;
constexpr size_t WS_WF1 = WS_WOUT + (size_t)DEPTH * DM * DM * 2;
constexpr size_t WS_WF2 = WS_WF1 + (size_t)DEPTH * DFF * DM * 2;
constexpr size_t WS_XN = WS_WF2 + (size_t)DEPTH * DM * DFF * 2;
constexpr size_t WS_H = WS_XN + (size_t)M * DM * 2;
constexpr size_t WS_PROJ = WS_H;
constexpr size_t WS_ATT = WS_PROJ + (size_t)M * INW * 2;
constexpr size_t WS_END = WS_H + (size_t)M * DFF * 2;
static_assert(WS_ATT + (size_t)M * DM * 2 <= WS_END, "overlay");
constexpr int LDS_BYTES = 147456;
static_assert(att::ATT_LDS <= 131072, "attention LDS");

__device__ __forceinline__ unsigned f2bf(float f) { unsigned u = __builtin_bit_cast(unsigned, f); return (u + 0x7fffu + ((u >> 16) & 1u)) >> 16; }
__device__ __forceinline__ unsigned pk2(float lo, float hi) { return f2bf(lo) | (f2bf(hi) << 16); }
__device__ __forceinline__ float wave_sum(float v) {
#pragma unroll
    for (int o = 1; o < 64; o <<= 1) v += __shfl_xor(v, o);
    return v;
}
__device__ __forceinline__ void transpose_item(const float* W, int K, int N, bf16* WT, LAS float* scr, int item, int lane) {
    const int nblk = N / 32, kb = item / nblk, nb = item % nblk, k0 = 64 * kb, n0 = 32 * nb;
#pragma unroll 16
    for (int i = 0; i < 32; ++i) { const int kk = 2 * i + (lane >> 5); scr[kk * 33 + (lane & 31)] = W[(size_t)(k0 + kk) * N + n0 + (lane & 31)]; }
    asm volatile("s_waitcnt lgkmcnt(0)" ::: "memory");
    const int c = lane & 7;
#pragma unroll
    for (int j = 0; j < 4; ++j) { const int n = (lane >> 3) + 8 * j; const LAS float* s = scr + (8 * c) * 33 + n;
        v4u o; o.x = pk2(s[0 * 33], s[1 * 33]); o.y = pk2(s[2 * 33], s[3 * 33]); o.z = pk2(s[4 * 33], s[5 * 33]); o.w = pk2(s[6 * 33], s[7 * 33]);
        *(v4u*)(WT + (size_t)(n0 + n) * K + k0 + 8 * c) = o; }
    asm volatile("s_waitcnt lgkmcnt(0)" ::: "memory");
}
__device__ __forceinline__ float xg_row_bf16(const float* xrow, const float* g, bf16* orow, int lane) {
    const f32x4* xr = (const f32x4*)xrow + lane; const f32x4* gr = (const f32x4*)g + lane;
    f32x4 v[8]; float s = 0.f;
#pragma unroll
    for (int j = 0; j < 8; ++j) { v[j] = xr[64 * j]; s += (v[j].x * v[j].x + v[j].y * v[j].y) + (v[j].z * v[j].z + v[j].w * v[j].w); }
    unsigned long long* o8 = (unsigned long long*)orow + lane;
#pragma unroll
    for (int j = 0; j < 8; ++j) { const f32x4 gg = gr[64 * j]; o8[64 * j] = (unsigned long long)pk2(v[j].x * gg.x, v[j].y * gg.y) | ((unsigned long long)pk2(v[j].z * gg.z, v[j].w * gg.w) << 32); }
    return wave_sum(s);
}
#define XB_TMO      128
#define XB_XCNT(j)  (256  + 64 * (j))
#define XB_XSUB(j)  (1280 + 64 * (j))
#define XB_XGEN(j)  (2304 + 64 * (j))
#define XB_TOP      3328
#define XB_TOPGEN   3392
#define XCD_BAR_WORDS 3456
#define XB_SPIN_CAP (1u << 18)

__device__ __forceinline__ unsigned xb_ld(unsigned* p)              { return __hip_atomic_load(p, __ATOMIC_RELAXED, __HIP_MEMORY_SCOPE_AGENT); }
__device__ __forceinline__ unsigned xb_add(unsigned* p, unsigned v) { return __hip_atomic_fetch_add(p, v, __ATOMIC_RELAXED, __HIP_MEMORY_SCOPE_AGENT); }
__device__ __forceinline__ unsigned xb_xcc_id() { return (unsigned)__builtin_amdgcn_s_getreg((3 << 11) | 20) & 0xFu; }
#define XB_SPIN(cond, bar) do { unsigned _sp = 0; while (cond) { __builtin_amdgcn_s_sleep(1); \
    if ((++_sp & 255u) == 0u) { if (xb_ld(&(bar)[XB_TMO])) break; if (_sp > XB_SPIN_CAP) { atomicAdd(&(bar)[XB_TMO], 1u); break; } } } } while (0)

struct XcdBarrier {
    unsigned* bar; unsigned x;
    volatile LAS unsigned* st;
};

__device__ __forceinline__ XcdBarrier xcd_barrier_post(unsigned* bar, volatile LAS unsigned* st) {
    XcdBarrier b; b.bar = bar; b.x = xb_xcc_id(); b.st = st;
    if (threadIdx.x == 0) (void)xb_add(&bar[XB_XCNT(b.x)], 1u);
    return b;
}
__device__ __forceinline__ void xcd_barrier_complete(unsigned* bar, unsigned x, unsigned& nloc, unsigned& nx) {
    const unsigned G = gridDim.x * gridDim.y * gridDim.z;
    unsigned sum, cnt, mine, sp = 0u;
    for (;;) {
        sum = 0u; cnt = 0u; mine = 0u;
#pragma unroll
        for (unsigned j = 0; j < 16; ++j) { const unsigned c = xb_ld(&bar[XB_XCNT(j)]); sum += c; cnt += (c > 0u) ? 1u : 0u; mine = (j == x) ? c : mine; }
        if (sum == G) break;
        __builtin_amdgcn_s_sleep(1);
        if ((++sp & 255u) == 0u) { if (xb_ld(&bar[XB_TMO])) break; if (sp > XB_SPIN_CAP) { atomicAdd(&bar[XB_TMO], 1u); break; } }
    }
    nloc = mine > 0u ? mine : 1u; nx = cnt > 0u ? cnt : 1u;
}

__device__ __forceinline__ void xcd_barrier(const XcdBarrier& b) {
    asm volatile("s_waitcnt vmcnt(0)" ::: "memory");
    __syncthreads();
    if (threadIdx.x == 0) {
        unsigned* bar = b.bar;
        __builtin_amdgcn_s_waitcnt(0);
        unsigned nloc = b.st[0], nx = b.st[1];
        if (nloc == 0u) { xcd_barrier_complete(bar, b.x, nloc, nx); b.st[0] = nloc; b.st[1] = nx; }
        const unsigned old = xb_add(&bar[XB_XSUB(b.x)], 1u);
        const unsigned gen = old / nloc;
        if (old + 1u == (gen + 1u) * nloc) {
            __builtin_amdgcn_fence(__ATOMIC_RELEASE, "agent");
            asm volatile("s_waitcnt vmcnt(0)" ::: "memory");
            const unsigned og = xb_add(&bar[XB_TOP], 1u);
            const unsigned tg = og / nx;
            if (og + 1u == (tg + 1u) * nx) xb_add(&bar[XB_TOPGEN], 1u);
            else XB_SPIN(xb_ld(&bar[XB_TOPGEN]) == tg, bar);
            __builtin_amdgcn_fence(__ATOMIC_ACQUIRE, "agent");
            xb_add(&bar[XB_XGEN(b.x)], 1u);
            asm volatile("s_waitcnt vmcnt(0)" ::: "memory");
        } else {
            XB_SPIN(xb_ld(&bar[XB_XGEN(b.x)]) == gen, bar);
            __builtin_amdgcn_fence(__ATOMIC_ACQUIRE, "agent");
            asm volatile("s_waitcnt vmcnt(0)" ::: "memory");
        }
    }
    __syncthreads();
}
struct Args { const float* in[16]; float* out; unsigned char* ws; int ph_lo, ph_hi; };
constexpr int N_PHASES = 2 + 5 * DEPTH;
constexpr size_t WS_BAR = 900 * 1024;
constexpr size_t WS_SSQ = 0;

__global__ void __launch_bounds__(NWAVES * 64, 2) mega_fwd(Args args) {
    extern __shared__ __attribute__((aligned(16))) unsigned char lds[];
    cg::grid_group grid = cg::this_grid();
    const int tid = threadIdx.x, wave = __builtin_amdgcn_readfirstlane(tid >> 6); int lane = tid & 63;
#define LAUNDER() asm volatile("v_mbcnt_lo_u32_b32 %0, -1, 0\n\tv_mbcnt_hi_u32_b32 %0, -1, %0" : "=v"(lane))
    const int G = gridDim.x, bx = blockIdx.x;
    const int vcu = (G % 8 == 0) ? (bx % 8) * (G / 8) + bx / 8 : bx;
    const int gw = vcu * NWAVES + wave, NGW = G * NWAVES;
    unsigned char* ws = args.ws;
    const float* x_prompt = args.in[0]; const float* x_sample = args.in[1]; const float* rel_bias = args.in[2];
    const float* norm1_g = args.in[3]; const float* w_in = args.in[4];
    const float* lq1 = args.in[5]; const float* lk1 = args.in[6]; const float* lq2 = args.in[7]; const float* lk2 = args.in[8];
    const float* subln_g = args.in[9]; const float* sink = args.in[10]; const float* w_out = args.in[11]; const float* norm2_g = args.in[12];
    const float* w_f1 = args.in[13]; const float* w_f2 = args.in[14]; const float* fin_g = args.in[15];
    float* out = args.out;
    bf16* Win_t = (bf16*)(ws + WS_WIN); bf16* Wout_t = (bf16*)(ws + WS_WOUT); bf16* Wf1_t = (bf16*)(ws + WS_WF1); bf16* Wf2_t = (bf16*)(ws + WS_WF2);
    float* SSQ = (float*)(ws + WS_SSQ);
    bf16* XN = (bf16*)(ws + WS_XN); bf16* HB = (bf16*)(ws + WS_H); bf16* PROJ = (bf16*)(ws + WS_PROJ); bf16* ATT = (bf16*)(ws + WS_ATT);
    const int lo = args.ph_lo, hi = args.ph_hi;
    volatile LAS unsigned* xst = (volatile LAS unsigned*)((LAS unsigned char*)lds + LDS_BYTES - 64);
    if (threadIdx.x < 16) xst[threadIdx.x] = 0u;
    __syncthreads();
    (void)xcd_barrier_post((unsigned*)(ws + WS_BAR), xst);
#define IN(k) (lo <= (k) && (k) < hi)
#define SEAM(k) do { if (IN(k) && IN((k) + 1)) { if ((k) == 0) grid.sync(); else { XcdBarrier xb_; xb_.bar = (unsigned*)(args.ws + WS_BAR); xb_.x = xb_xcc_id(); xb_.st = (volatile LAS unsigned*)((LAS unsigned char*)lds + LDS_BYTES - 64); xcd_barrier(xb_); } } } while (0)

    if (IN(0)) {
        LAUNDER();
        LAS float* scr = (LAS float*)((LAS unsigned char*)lds + wave * 16384);
        constexpr int I_IN = (DM / 64) * (INW / 32), I_OUT = (DM / 64) * (DM / 32), I_F1 = (DM / 64) * (DFF / 32), I_F2 = (DFF / 64) * (DM / 32);
        constexpr int I_L = I_IN + I_OUT + I_F1 + I_F2;
        for (int it = gw; it < DEPTH * I_L; it += NGW) {
            const int l = it / I_L; int r = it % I_L;
            if (r < I_IN) { transpose_item(w_in + (size_t)l * DM * INW, DM, INW, Win_t + (size_t)l * INW * DM, scr, r, lane); continue; } r -= I_IN;
            if (r < I_OUT) { transpose_item(w_out + (size_t)l * DM * DM, DM, DM, Wout_t + (size_t)l * DM * DM, scr, r, lane); continue; } r -= I_OUT;
            if (r < I_F1) { transpose_item(w_f1 + (size_t)l * DM * DFF, DM, DFF, Wf1_t + (size_t)l * DFF * DM, scr, r, lane); continue; } r -= I_F1;
            transpose_item(w_f2 + (size_t)l * DFF * DM, DFF, DM, Wf2_t + (size_t)l * DM * DFF, scr, r, lane);
        }
        for (int i = (vcu * NWAVES * 64 + tid); i < 4 * M; i += G * NWAVES * 64) SSQ[M + i] = 0.f;
        for (int m = gw; m < M; m += NGW) { const float* xr = m < M_P ? x_prompt + (size_t)m * DM : x_sample + (size_t)(m - M_P) * DM; const float sq = xg_row_bf16(xr, norm1_g, XN + (size_t)m * DM, lane); if (lane == 0) SSQ[m] = sq; }
    }
    SEAM(0);
#pragma unroll
    for (int l = 0; l < DEPTH; ++l) {
        const int pb = 1 + 5 * l;
        if (IN(pb)) {
            pg8::Gemm g{XN, Win_t + (size_t)l * INW * DM, M, INW, DM}; pg8::StaticOrder S; S.init(M, INW, G, bx);
            pg8::EpiBf16<0> E{PROJ, INW, SSQ + (size_t)(2 * l) * M};
            pg8::gemm_phase<pg8::EpiBf16<0>, pg8::StaticOrder, true, true>((LAS unsigned char*)lds, g, S, E);
        }
        SEAM(pb);
        if (IN(pb + 1)) {
            LAUNDER();
            const float lambda_init = l == 0 ? 0.2f : (l == 1 ? 0.35550906758f : 0.8f - 0.6f * expf(-0.3f * (float)l));
            float d1 = lq1[l * 64 + lane] * lk1[l * 64 + lane], d2 = lq2[l * 64 + lane] * lk2[l * 64 + lane];
            d1 = wave_sum(d1); d2 = wave_sum(d2);
            const float lam = __uint_as_float(__builtin_amdgcn_readfirstlane(__float_as_uint(expf(d1) - expf(d2) + lambda_init)));
            const float oscl = __uint_as_float(__builtin_amdgcn_readfirstlane(__float_as_uint(1.f - lambda_init)));
#pragma unroll 1
            for (int U = vcu; U < 2560; U += G) {
                int pair, qb, S; size_t row0;
                if (U < 2048) { const int r = U >> 8, v = U & 255, x = v >> 5, cu = v & 31; pair = x * 4 + (r >> 1); qb = (r & 1) * 32 + cu; S = SEQ_P; row0 = (size_t)(pair >> 3) * SEQ_P; }
                else { const int U2 = U - 2048; const int r = U2 >> 8, v = U2 & 255, x = v >> 5, cu = v & 31; pair = x * 2 + r; qb = cu; S = SEQ_S; row0 = (size_t)M_P + (size_t)(pair >> 3) * SEQ_S; }
                const int h = pair & 7;
                if (false) att::attn_unit<0, 0>(PROJ + (row0 + qb * 128) * INW + h * 128, PROJ + row0 * INW + 1024 + h * 128, PROJ + row0 * INW + 2048 + h * 128,
                                  ATT + (row0 + qb * 128) * DM + h * 128, qb * 128, 0, S / 64, rel_bias + h, 0.f, lam, oscl, subln_g + l * 128, (char*)lds);
                else att::attn_unit<0, 1>(PROJ + (row0 + qb * 128) * INW + h * 128, PROJ + row0 * INW + 1024 + h * 128, PROJ + row0 * INW + 2048 + h * 128,
                                  ATT + (row0 + qb * 128) * DM + h * 128, qb * 128, 0, S / 64, rel_bias + h, 0.f, lam, oscl, subln_g + l * 128, (char*)lds);
            }
#pragma unroll 1
            for (int U3 = vcu; U3 < 1280; U3 += G) {
                const int r = U3 >> 8, v = U3 & 255; const int w = v * 5 + r; const int rbk = w >> 3, hq = w & 7, kvh = hq >> 2;
                const size_t grow = (size_t)rbk * 256;
                const bool isP = grow < (size_t)M_P; const int S = isP ? SEQ_P : SEQ_S;
                const size_t row0 = isP ? (grow / SEQ_P) * SEQ_P : (size_t)M_P + ((grow - M_P) / SEQ_S) * SEQ_S;
                const int q0 = (int)(grow - row0);
                const int kb = q0 - 128 < 0 ? 0 : q0 - 128, ke = q0 + 384 > S ? S : q0 + 384;
                if (false) att::attn_unit<1, 0>(PROJ + grow * INW + 3072 + hq * 128, PROJ + row0 * INW + 4096 + kvh * 128, PROJ + row0 * INW + 4352 + kvh * 128,
                                  ATT + grow * DM + 1024 + hq * 128, q0, kb, (ke - kb) / 64, rel_bias + 8 + hq, sink[l * 8 + hq], 0.f, 1.f, nullptr, (char*)lds);
                else att::attn_unit<1, 1>(PROJ + grow * INW + 3072 + hq * 128, PROJ + row0 * INW + 4096 + kvh * 128, PROJ + row0 * INW + 4352 + kvh * 128,
                                  ATT + grow * DM + 1024 + hq * 128, q0, kb, (ke - kb) / 64, rel_bias + 8 + hq, sink[l * 8 + hq], 0.f, 1.f, nullptr, (char*)lds);
            }
            __syncthreads();
        }
        SEAM(pb + 1);
        if (IN(pb + 2)) {
            pg8::Gemm g{ATT, Wout_t + (size_t)l * DM * DM, M, DM, DM}; pg8::StaticOrder S; S.init(M, DM, G, bx);
            pg8::EpiResF32 E{l == 0 ? x_prompt : out, l == 0 ? x_sample : out + (size_t)M_P * DM, M_P, out, XN, norm2_g + l * DM, SSQ + (size_t)(2 * l + 1) * M, nullptr};
            pg8::gemm_phase<pg8::EpiResF32, pg8::StaticOrder, true, true>((LAS unsigned char*)lds, g, S, E);
        }
        SEAM(pb + 2);
        if (IN(pb + 3)) {
            pg8::Gemm g{XN, Wf1_t + (size_t)l * DFF * DM, M, DFF, DM}; pg8::StaticOrder S; S.init(M, DFF, G, bx);
            pg8::EpiBf16<1> E{HB, DFF, nullptr};
            pg8::gemm_phase<pg8::EpiBf16<1>, pg8::StaticOrder, true, true>((LAS unsigned char*)lds, g, S, E);
        }
        SEAM(pb + 3);
        if (IN(pb + 4)) {
            pg8::Gemm g{HB, Wf2_t + (size_t)l * DM * DFF, M, DM, DFF}; pg8::StaticOrder S; S.init(M, DM, G, bx);
            pg8::EpiResF32 E{out, out + (size_t)M_P * DM, M_P, out, l + 1 < DEPTH ? XN : nullptr, l + 1 < DEPTH ? norm1_g + (l + 1) * DM : fin_g, SSQ + (size_t)(2 * l + 2) * M, SSQ + (size_t)(2 * l + 1) * M};
            pg8::gemm_phase<pg8::EpiResF32, pg8::StaticOrder, true, true>((LAS unsigned char*)lds, g, S, E);
        }
        SEAM(pb + 4);
    }
    if (IN(1 + 5 * DEPTH)) {
        LAUNDER();
        const float* sq = SSQ + (size_t)(2 * DEPTH) * M;
        for (int m = gw; m < M; m += NGW) { f32x4* xr = (f32x4*)(out + (size_t)m * DM) + lane; const f32x4* gr = (const f32x4*)fin_g + lane; const float rs = 1.f / sqrtf(sq[m] * (1.f / DM) + 1e-6f);
#pragma unroll
            for (int j = 0; j < 8; ++j) xr[64 * j] = xr[64 * j] * rs * gr[64 * j]; }
    }
#undef IN
#undef SEAM
}

extern "C" void kernel_launch(void* const* d_in, const int* in_sizes, int n_in, void* d_out, int out_size, void* d_ws, size_t ws_size, hipStream_t stream) {
    static int grid = 0;
    if (grid == 0) {
        if (n_in != 16 || in_sizes[0] != M_P * DM || in_sizes[1] != M_S * DM || out_size != M * DM || ws_size < WS_END) {
            fprintf(stderr, "kernel_launch: shape/workspace mismatch: n_in %d in0 %d in1 %d out %d ws %zu (need %zu)\n", n_in, n_in > 0 ? in_sizes[0] : -1, n_in > 1 ? in_sizes[1] : -1, out_size, ws_size, (size_t)WS_END);
            grid = -1; return; }
        int dev = 0, cus = 0, per_cu = 0;
        hipGetDevice(&dev); hipDeviceGetAttribute(&cus, hipDeviceAttributeMultiprocessorCount, dev);
        if (hipFuncSetAttribute((const void*)mega_fwd, hipFuncAttributeMaxDynamicSharedMemorySize, LDS_BYTES) != hipSuccess) { fprintf(stderr, "kernel_launch: hipFuncSetAttribute failed\n"); grid = -1; return; }
        if (hipOccupancyMaxActiveBlocksPerMultiprocessor(&per_cu, (const void*)mega_fwd, NWAVES * 64, LDS_BYTES) != hipSuccess || per_cu < 1) { fprintf(stderr, "kernel_launch: occupancy query gave %d\n", per_cu); per_cu = 1; }
        (void)hipGetLastError();
        grid = cus * per_cu;
    }
    if (grid < 0) return;
    if (hipMemsetAsync((char*)d_ws + WS_BAR, 0, XCD_BAR_WORDS * 4, stream) != hipSuccess) { fprintf(stderr, "kernel_launch: hipMemsetAsync failed\n"); return; }
    Args a{};
    for (int i = 0; i < 16; ++i) a.in[i] = (const float*)d_in[i];
    a.out = (float*)d_out; a.ws = (unsigned char*)d_ws;
#if MK_MULTI
    for (int p = 0; p < N_PHASES; ++p) { a.ph_lo = p; a.ph_hi = p + 1; void* kargs[] = {&a};
        hipError_t e = hipLaunchCooperativeKernel((const void*)mega_fwd, dim3(grid), dim3(NWAVES * 64), kargs, LDS_BYTES, stream);
        if (e != hipSuccess) { fprintf(stderr, "kernel_launch: launch %d failed: %s (grid %d)\n", p, hipGetErrorString(e), grid); break; } }
#else
    a.ph_lo = 0; a.ph_hi = N_PHASES; void* kargs[] = {&a};
    hipError_t e = hipLaunchCooperativeKernel((const void*)mega_fwd, dim3(grid), dim3(NWAVES * 64), kargs, LDS_BYTES, stream);
    if (e != hipSuccess) fprintf(stderr, "kernel_launch: cooperative launch failed: %s (grid %d)\n", hipGetErrorString(e), grid);
#endif
}
```

```cpp
#include <hip/hip_runtime.h>
#include <hip/hip_bf16.h>
#include <hip/hip_cooperative_groups.h>
#include <cstdio>
#include <cstdint>
namespace cg = cooperative_groups;

#ifndef MK_MULTI
#define MK_MULTI 0
#endif


namespace pg8 {
#define PG8_LAS __attribute__((address_space(3)))
typedef unsigned short bf16_t;
typedef short bf16x8 __attribute__((ext_vector_type(8)));
typedef float f32x4 __attribute__((ext_vector_type(4)));
typedef unsigned u32x4 __attribute__((ext_vector_type(4)));
constexpr int BM = 256, BK = 64, HALF = 128, HTB = HALF * BK * 2  , STAGE_BYTES = 8 * HTB, NXCD = 8, WGM = 8;

__host__ __device__ __forceinline__ int lds_byte(int r, int c) { const int st = (r >> 4) * 2 + (c >> 5), rr = r & 15, cc = c & 31, ob = rr * 64 + cc * 2; return st * 1024 + (ob ^ (((ob >> 9) & 1) << 5)); }
__host__ __device__ __forceinline__ void stage_rc(int b, int& R, int& C) { const int st = b / 1024, sb = b % 1024, swz = sb ^ (((sb >> 9) & 1) << 5); R = (st >> 1) * 16 + swz / 64; C = (st & 1) * 32 + (swz % 64) / 2; }
__host__ __device__ __forceinline__ int perm32(int rho) { const int n = rho >> 4, i = rho & 15; return 8 * (i >> 2) + 4 * n + (i & 3); }

struct Unit { int pm, pn; };
struct Gemm { const bf16_t* A; const bf16_t* Bt; int M, N, K; };

struct StaticOrder {
    int nM, nN, nwg, G, c;
    __host__ __device__ void init(int M, int N, int G_, int c_) { nM = M / BM; nN = N / BM; nwg = nM * nN; G = G_; c = c_; }
    __host__ __device__ bool next(int i, Unit& u) const {
        const long L = (long)i * G + c; if (L >= nwg) return false;
        int wgid = (int)L; { const int q = nwg / NXCD, r = nwg % NXCD, xcd = wgid % NXCD, off = wgid / NXCD; wgid = (xcd < r ? xcd * (q + 1) : r * (q + 1) + (xcd - r) * q) + off; }
        const int nig = WGM * nN, gid = wgid / nig, fm = gid * WGM, gsz = (nM - fm) < WGM ? (nM - fm) : WGM;
        u.pm = fm + ((wgid % nig) % gsz); u.pn = (wgid % nig) / gsz; return true;
    }
    __device__ __forceinline__ void a_ready(const Unit&) const {}
    __device__ __forceinline__ void done(const Unit&) const {}
};

typedef unsigned u32x4 __attribute__((ext_vector_type(4)));
__device__ __forceinline__ unsigned cvt_pk_bf16(float lo, float hi) { unsigned r; asm volatile("v_cvt_pk_bf16_f32 %0, %1, %2" : "=v"(r) : "v"(lo), "v"(hi)); return r; }

template <int ACT  > struct EpiBf16 {
    static constexpr bool PERM = true, AFTER_DRAIN = false;
    bf16_t* O; int ldc; const float* ssq;
    __device__ __forceinline__ void operator()(const f32x4 (&acc)[2][2][4][2], const Unit& u, int wr, int wc, int fr, int fq) const {
        asm volatile("" : "+v"(fr), "+v"(fq));
        const int row0 = u.pm * BM + wr * 64 + fr; const int col0 = u.pn * BM + wc * 32 + 8 * fq;
#pragma unroll
        for (int ai = 0; ai < 2; ++ai)
#pragma unroll
            for (int m = 0; m < 4; ++m) { const int row = row0 + ai * HALF + m * 16; bf16_t* rowp = O + (size_t)row * ldc + col0;
                const float rs = ssq ? __builtin_amdgcn_rsqf(ssq[row] * (1.f / 2048.f) + 1e-6f) : 1.f;
#pragma unroll
                for (int bj = 0; bj < 2; ++bj) { f32x4 v0 = acc[ai][bj][m][0] * rs, v1 = acc[ai][bj][m][1] * rs;
                    if (ACT == 1) {
#pragma unroll
                        for (int e = 0; e < 4; ++e) { float a = fmaxf(v0[e], 0.f), b = fmaxf(v1[e], 0.f); v0[e] = a * a; v1[e] = b * b; } }
                    u32x4 w; w.x = cvt_pk_bf16(v0[0], v0[1]); w.y = cvt_pk_bf16(v0[2], v0[3]); w.z = cvt_pk_bf16(v1[0], v1[1]); w.w = cvt_pk_bf16(v1[2], v1[3]);
                    __builtin_nontemporal_store(w, (u32x4*)(rowp + bj * HALF)); } }
    }
};
struct EpiResF32 {
    static constexpr bool PERM = true, AFTER_DRAIN = false;
    const float* b0; const float* b1; int split; float* out; bf16_t* xn; const float* g; float* ssq; const float* rs2;
    __device__ __forceinline__ void operator()(const f32x4 (&acc)[2][2][4][2], const Unit& u, int wr, int wc, int fr, int fq) const {
        asm volatile("" : "+v"(fr), "+v"(fq));
        const int col0 = u.pn * BM + wc * 32 + 8 * fq;
        const int rt = u.pm * BM; const float* bb = (rt < split) ? b0 + (size_t)rt * 2048 : b1 + (size_t)(rt - split) * 2048; float* oo = out + (size_t)rt * 2048; bf16_t* xx = xn + (size_t)rt * 2048;
        float sacc[2][4];
        f32x4 gv[2][2];
#pragma unroll
        for (int bj = 0; bj < 2; ++bj) { gv[bj][0] = *(const f32x4*)(g + col0 + bj * HALF); gv[bj][1] = *(const f32x4*)(g + col0 + bj * HALF + 4); }
#pragma unroll
        for (int ai = 0; ai < 2; ++ai) {
            f32x4 pre[4][2][2]; float rq[4];
#pragma unroll
            for (int m = 0; m < 4; ++m) { const size_t off = (size_t)(ai * HALF + wr * 64 + m * 16 + fr) * 2048 + col0; rq[m] = rs2 ? rs2[rt + ai * HALF + wr * 64 + m * 16 + fr] : 0.f;
#pragma unroll
                for (int bj = 0; bj < 2; ++bj) { pre[m][bj][0] = *(const f32x4*)(bb + off + bj * HALF); pre[m][bj][1] = *(const f32x4*)(bb + off + bj * HALF + 4); } }
            asm volatile("" ::: "memory");
#pragma unroll
            for (int m = 0; m < 4; ++m) { const int rl = ai * HALF + wr * 64 + m * 16 + fr; const size_t off = (size_t)rl * 2048 + col0; float s = 0.f; const float sc = rs2 ? __builtin_amdgcn_rcpf(rq[m] * (1.f / 2048.f) + 1e-6f) : 1.f;
#pragma unroll
                for (int bj = 0; bj < 2; ++bj) {
                    const f32x4 v0 = pre[m][bj][0] + acc[ai][bj][m][0] * sc, v1 = pre[m][bj][1] + acc[ai][bj][m][1] * sc;
                    __builtin_nontemporal_store(v0, (f32x4*)(oo + off + bj * HALF)); __builtin_nontemporal_store(v1, (f32x4*)(oo + off + bj * HALF + 4));
                    s += (v0[0] * v0[0] + v0[1] * v0[1]) + (v0[2] * v0[2] + v0[3] * v0[3]) + (v1[0] * v1[0] + v1[1] * v1[1]) + (v1[2] * v1[2] + v1[3] * v1[3]);
                    const f32x4 a = v0 * gv[bj][0], b = v1 * gv[bj][1];
                    u32x4 w; w.x = cvt_pk_bf16(a[0], a[1]); w.y = cvt_pk_bf16(a[2], a[3]); w.z = cvt_pk_bf16(b[0], b[1]); w.w = cvt_pk_bf16(b[2], b[3]);
                    if (xn) *(u32x4*)(xx + off + bj * HALF) = w; }
                s += __shfl_xor(s, 16); s += __shfl_xor(s, 32); sacc[ai][m] = s; }
            asm volatile("" ::: "memory");
        }
        if (fq == 0) {
#pragma unroll
            for (int ai = 0; ai < 2; ++ai)
#pragma unroll
                for (int m = 0; m < 4; ++m) atomicAdd(ssq + rt + ai * HALF + wr * 64 + m * 16 + fr, sacc[ai][m]); }
    }
};
template <class Epi, class Sched, bool ALIGN_EPI = false, bool SP2 = false>
__device__ __forceinline__ void gemm_phase(PG8_LAS unsigned char* lds, const Gemm g, const Sched& S, const Epi& E) {
    int tid_ = threadIdx.x; asm volatile("" : "+v"(tid_));
    const int tid = tid_, wid = __builtin_amdgcn_readfirstlane(tid >> 6), lane = tid & 63, wr = wid >> 2, wc = wid & 3, fr = lane & 15, fq = lane >> 4;
    const int K = g.K, nt = K / BK;
    unsigned voffA[2], voffB[2];
#pragma unroll
    for (int i = 0; i < 2; ++i) { int R, C; stage_rc(tid * 16 + i * 8192, R, C); const int Rb = Epi::PERM ? ((R & ~31) + perm32(R & 31)) : R;
        voffA[i] = (unsigned)(R * K + C) * 2u; voffB[i] = (unsigned)(Rb * K + C) * 2u; }
    const size_t kstep = (size_t)(BK * 2);
    const size_t hstep = (size_t)HALF * K * 2;
    const size_t tstep = 2 * hstep;
    const unsigned ldsw = (unsigned)wid * 1024u;
    const int aoff = lds_byte(wr * 64 + fr, fq * 8), boff = lds_byte(wc * 32 + fr, fq * 8);
#define PG8_SA(b, h) (((b) * 2 + (h)) * HTB)
#define PG8_SB(b, h) ((4 + (b) * 2 + (h)) * HTB)
#define PG8_STAGE(bufoff, gbase, voff) do { _Pragma("unroll") for (int _i = 0; _i < 2; ++_i) \
        __builtin_amdgcn_global_load_lds((const unsigned*)((const char*)(gbase) + (voff)[_i]), (PG8_LAS unsigned*)(lds + (bufoff) + ldsw + _i * 8192), 16, 0, 0); } while (0)
#define PG8_LDA(dst, b, h) do { _Pragma("unroll") for (int m = 0; m < 4; ++m) _Pragma("unroll") for (int k = 0; k < 2; ++k) dst[m][k] = *(const PG8_LAS bf16x8*)(lds + PG8_SA(b, h) + aoff + m * 2048 + k * 1024); } while (0)
#define PG8_LDB(dst, b, h) do { _Pragma("unroll") for (int n = 0; n < 2; ++n) _Pragma("unroll") for (int k = 0; k < 2; ++k) dst[n][k] = *(const PG8_LAS bf16x8*)(lds + PG8_SB(b, h) + boff + n * 2048 + k * 1024); } while (0)
#define PG8_MMA(ai, bj, At, Bt) do { __builtin_amdgcn_s_setprio(1); _Pragma("unroll") for (int m = 0; m < 4; ++m) _Pragma("unroll") for (int n = 0; n < 2; ++n) _Pragma("unroll") for (int k = 0; k < 2; ++k) \
        acc[ai][bj][m][n] = __builtin_amdgcn_mfma_f32_16x16x32_bf16(Bt[n][k], At[m][k], acc[ai][bj][m][n], 0, 0, 0); __builtin_amdgcn_s_setprio(0); } while (0)
#define PG8_WAIT_V(n) asm volatile("s_waitcnt vmcnt(" #n ")" ::: "memory")
#define PG8_WAIT_L(n) asm volatile("s_waitcnt lgkmcnt(" #n ")" ::: "memory")
#define PG8_BAR __builtin_amdgcn_s_barrier()
#define PG8_SCHED __builtin_amdgcn_sched_barrier(0)
    Unit cur, nxt; int ui = 0;
    if (!S.next(0, cur)) return;
    f32x4 acc[2][2][4][2];
#pragma unroll
    for (int a = 0; a < 2; ++a)
#pragma unroll
        for (int b = 0; b < 2; ++b)
#pragma unroll
            for (int m = 0; m < 4; ++m)
#pragma unroll
                for (int n = 0; n < 2; ++n) acc[a][b][m][n] = (f32x4){0.f, 0.f, 0.f, 0.f};
    bf16x8 At[4][2], B0[2][2], B1[2][2];
    const char* cA = (const char*)g.A + (size_t)cur.pm * tstep; const char* cB = (const char*)g.Bt + (size_t)cur.pn * tstep;
    S.a_ready(cur);
    if constexpr (SP2) {
        PG8_STAGE(PG8_SB(0, 0), cB, voffB); PG8_STAGE(PG8_SB(0, 1), cB + hstep, voffB); PG8_STAGE(PG8_SA(0, 0), cA, voffA); PG8_STAGE(PG8_SA(0, 1), cA + hstep, voffA);
        if (wr == 1) PG8_BAR;
        PG8_WAIT_V(2); PG8_BAR;
        PG8_STAGE(PG8_SB(1, 0), cB + kstep, voffB); PG8_STAGE(PG8_SA(1, 0), cA + kstep, voffA); PG8_STAGE(PG8_SB(1, 1), cB + hstep + kstep, voffB);
        PG8_WAIT_V(6); PG8_BAR;
    } else {
        PG8_STAGE(PG8_SB(0, 0), cB, voffB); PG8_STAGE(PG8_SA(0, 0), cA, voffA); PG8_STAGE(PG8_SB(0, 1), cB + hstep, voffB); PG8_STAGE(PG8_SA(0, 1), cA + hstep, voffA);
        if (wr == 1) PG8_BAR;
        PG8_WAIT_V(4); PG8_BAR;
        PG8_STAGE(PG8_SB(1, 0), cB + kstep, voffB); PG8_STAGE(PG8_SA(1, 0), cA + kstep, voffA); PG8_STAGE(PG8_SB(1, 1), cB + hstep + kstep, voffB);
        PG8_WAIT_V(6); PG8_BAR;
    }
    for (;;) {
        const bool has_next = S.next(ui + 1, nxt);
        const char* nA = has_next ? (const char*)g.A + (size_t)nxt.pm * tstep : cA; const char* nB = has_next ? (const char*)g.Bt + (size_t)nxt.pn * tstep : cB;
        for (int t = 0; t < nt; t += 2) {
            const bool last = (t == nt - 2);
            const char* a1 = cA + (size_t)(t + 1) * kstep;
            const char* a2 = last ? nA : cA + (size_t)(t + 2) * kstep; const char* b2 = last ? nB : cB + (size_t)(t + 2) * kstep;
            const char* a3 = a2 + kstep; const char* b3 = b2 + kstep;
            if (last && has_next) S.a_ready(nxt);
            if constexpr (SP2) {
            PG8_LDB(B0, 0, 0); PG8_LDB(B1, 0, 1); PG8_SCHED; PG8_LDA(At, 0, 0); PG8_STAGE(PG8_SA(1, 1), a1 + hstep, voffA);
            PG8_WAIT_V(8); PG8_WAIT_L(0); PG8_BAR; PG8_MMA(0, 0, At, B0); PG8_MMA(0, 1, At, B1); PG8_BAR; PG8_SCHED;
            PG8_LDA(At, 0, 1); PG8_STAGE(PG8_SB(0, 0), b2, voffB); PG8_STAGE(PG8_SB(0, 1), b2 + hstep, voffB); PG8_STAGE(PG8_SA(0, 0), a2, voffA);
            PG8_WAIT_V(8); PG8_WAIT_L(0); PG8_BAR; PG8_MMA(1, 0, At, B0); PG8_MMA(1, 1, At, B1); PG8_BAR; PG8_SCHED;
            PG8_LDB(B0, 1, 0); PG8_LDB(B1, 1, 1); PG8_SCHED; PG8_LDA(At, 1, 0); PG8_STAGE(PG8_SA(0, 1), a2 + hstep, voffA);
            PG8_WAIT_V(8); PG8_WAIT_L(0); PG8_BAR; PG8_MMA(0, 0, At, B0); PG8_MMA(0, 1, At, B1); PG8_BAR; PG8_SCHED;
            PG8_LDA(At, 1, 1); PG8_STAGE(PG8_SB(1, 0), b3, voffB); PG8_STAGE(PG8_SB(1, 1), b3 + hstep, voffB); PG8_STAGE(PG8_SA(1, 0), a3, voffA);
            PG8_WAIT_V(8); PG8_WAIT_L(0); PG8_BAR; PG8_MMA(1, 0, At, B0); PG8_MMA(1, 1, At, B1); PG8_BAR; PG8_SCHED;
            } else {
            PG8_LDB(B0, 0, 0); PG8_SCHED; PG8_LDA(At, 0, 0); PG8_STAGE(PG8_SA(1, 1), a1 + hstep, voffA);
            PG8_WAIT_L(8); PG8_BAR; PG8_WAIT_L(0); PG8_MMA(0, 0, At, B0); PG8_BAR; PG8_SCHED;
            PG8_LDB(B1, 0, 1); PG8_STAGE(PG8_SB(0, 0), b2, voffB);
            PG8_BAR; PG8_WAIT_L(0); PG8_MMA(0, 1, At, B1); PG8_BAR;
            PG8_LDA(At, 0, 1); PG8_STAGE(PG8_SA(0, 0), a2, voffA);
            PG8_BAR; PG8_WAIT_L(0); PG8_MMA(1, 0, At, B0); PG8_BAR; PG8_SCHED;
            PG8_STAGE(PG8_SB(0, 1), b2 + hstep, voffB);
            PG8_WAIT_V(6); PG8_BAR; PG8_MMA(1, 1, At, B1); PG8_BAR;
            PG8_LDB(B0, 1, 0); PG8_SCHED; PG8_LDA(At, 1, 0); PG8_STAGE(PG8_SA(0, 1), a2 + hstep, voffA);
            PG8_WAIT_L(8); PG8_BAR; PG8_WAIT_L(0); PG8_MMA(0, 0, At, B0); PG8_BAR; PG8_SCHED;
            PG8_LDB(B1, 1, 1); PG8_STAGE(PG8_SB(1, 0), b3, voffB);
            PG8_BAR; PG8_WAIT_L(0); PG8_MMA(0, 1, At, B1); PG8_BAR;
            PG8_LDA(At, 1, 1); PG8_STAGE(PG8_SA(1, 0), a3, voffA);
            PG8_BAR; PG8_WAIT_L(0); PG8_MMA(1, 0, At, B0); PG8_BAR; PG8_SCHED;
            PG8_STAGE(PG8_SB(1, 1), b3 + hstep, voffB);
            PG8_WAIT_V(6); PG8_BAR; PG8_MMA(1, 1, At, B1); PG8_BAR;
            }
        }
        if constexpr (ALIGN_EPI) { if (wr == 0) PG8_BAR; }
        if constexpr (!Epi::AFTER_DRAIN) { E(acc, cur, wr, wc, fr, fq); S.done(cur); }
        if (!has_next) break;
#pragma unroll
        for (int a = 0; a < 2; ++a)
#pragma unroll
            for (int b = 0; b < 2; ++b)
#pragma unroll
                for (int m = 0; m < 4; ++m)
#pragma unroll
                    for (int n = 0; n < 2; ++n) acc[a][b][m][n] = (f32x4){0.f, 0.f, 0.f, 0.f};
        cur = nxt; cA = nA; cB = nB; ++ui;
        if constexpr (ALIGN_EPI) { if (wr == 1) PG8_BAR; }
    }
    PG8_WAIT_V(0);
    if constexpr (!ALIGN_EPI) { if (wr == 0) PG8_BAR; }
    PG8_BAR;
    if constexpr (Epi::AFTER_DRAIN) { E.fused(acc, cur, wr, wc, fr, fq, lds, wid, lane); S.done(cur); }
#undef PG8_SA
#undef PG8_SB
#undef PG8_STAGE
#undef PG8_LDA
#undef PG8_LDB
#undef PG8_MMA
#undef PG8_WAIT_V
#undef PG8_WAIT_L
#undef PG8_BAR
#undef PG8_SCHED
}
}
namespace att {
using bf16 = unsigned short;
using bf16x8 = __attribute__((ext_vector_type(8))) short;
using s16x4  = __attribute__((ext_vector_type(4))) short;
using f32x16 = __attribute__((ext_vector_type(16))) float;
using u32x4  = __attribute__((ext_vector_type(4))) unsigned;
constexpr int KVBLK = 64, LDP = 4608, LDO = 2048;
constexpr int SHM_V = 16384, SHM_K = 16384;
constexpr int SLOT = SHM_V + SHM_K, NSLOT = 3;
constexpr int OFF_V = 0, OFF_K = SHM_V, OFF_WS = NSLOT * SLOT, OFF_TAB = OFF_WS + 8 * 64 * 4, ATT_LDS = OFF_TAB + 272 * 4;
constexpr float LOG2E = 1.4426950408889634f;
constexpr float THR = 8.f;
constexpr float NEGB = -1e30f;
#define KSWZ(row, colB) ((row) * 256 + ((colB) ^ (((row) & 7) << 4)))
#define SBAR() __builtin_amdgcn_sched_barrier(0)
__device__ __forceinline__ int crow(int r, int hi) { return (r & 3) + 8 * (r >> 2) + 4 * hi; }
__device__ __forceinline__ unsigned cvtpk(float lo, float hi) { unsigned r; asm volatile("v_cvt_pk_bf16_f32 %0, %1, %2" : "=v"(r) : "v"(lo), "v"(hi)); return r; }
__device__ __forceinline__ bf16x8 ld8(const bf16* p) { return *reinterpret_cast<const bf16x8*>(p); }

__device__ __forceinline__ float max3f(float a, float b, float c) { float r; asm("v_max3_f32 %0, %1, %2, %3" : "=v"(r) : "v"(a), "v"(b), "v"(c)); return r; }
__device__ __forceinline__ int t5_bucket(int rel) {
  const int n = rel < 0 ? -rel : rel; int b;
  if (n < 8) b = n; else { int l = (31 - __builtin_clz((unsigned)(n * n))) - 6; b = 8 + l; if (b > 15) b = 15; }
  return (rel > 0 ? 16 : 0) + b;
}

__device__ __forceinline__ void partialSM(f32x16& p0, f32x16& p1, float& m_reg, float& alpha, float Ce, float be) {
  float pmax = max3f(p0[0], p0[1], p1[0]), pmb = max3f(p0[2], p0[3], p1[1]);
  pmax = max3f(pmax, p1[2], p1[3]);
#pragma unroll
  for (int r = 4; r < 16; r += 4) { pmax = max3f(pmax, p0[r], p0[r + 1]); pmb = max3f(pmb, p0[r + 2], p0[r + 3]); pmax = max3f(pmax, p1[r], p1[r + 1]); pmb = max3f(pmb, p1[r + 2], p1[r + 3]); }
  pmax = max3f(pmax, pmb, pmb);
  { auto rr = __builtin_amdgcn_permlane32_swap(__float_as_uint(pmax), __float_as_uint(pmax), false, false);
    pmax = fmaxf(__uint_as_float(rr[0]), __uint_as_float(rr[1])); }
  pmax = fmaf(pmax, Ce, be);
  float mn;
  if (__builtin_expect(__all(pmax - m_reg <= THR), 1)) { mn = m_reg; alpha = 1.f; }
  else { mn = fmaxf(m_reg, pmax); alpha = __builtin_amdgcn_exp2f(m_reg - mn); m_reg = mn; }
  const float off = be - mn;
#pragma unroll
  for (int r = 0; r < 16; ++r) p0[r] = fmaf(p0[r], Ce, off);
#pragma unroll
  for (int r = 0; r < 16; ++r) p1[r] = fmaf(p1[r], Ce, off);
#pragma unroll
  for (int r = 0; r < 16; ++r) p0[r] = __builtin_amdgcn_exp2f(p0[r]);
}
__device__ __forceinline__ void finishSM(f32x16& p0, f32x16& p1, float alpha, float& l_reg, bf16x8& pa0, bf16x8& pa1, bf16x8& pa2, bf16x8& pa3) {
#pragma unroll
  for (int r = 0; r < 16; ++r) p1[r] = __builtin_amdgcn_exp2f(p1[r]);
  float ps = 0;
#pragma unroll
  for (int r = 0; r < 16; ++r) ps += p0[r];
#pragma unroll
  for (int r = 0; r < 16; ++r) ps += p1[r];
  { auto rr = __builtin_amdgcn_permlane32_swap(__float_as_uint(ps), __float_as_uint(ps), false, false);
    ps = __uint_as_float(rr[0]) + __uint_as_float(rr[1]); }
  l_reg = l_reg * alpha + ps;
#define PK4(P, BASE, OUT) do { unsigned a0 = cvtpk(P[BASE + 0], P[BASE + 1]), a1 = cvtpk(P[BASE + 2], P[BASE + 3]);   \
    unsigned b0 = cvtpk(P[BASE + 4], P[BASE + 5]), b1 = cvtpk(P[BASE + 6], P[BASE + 7]);                              \
    auto r0 = __builtin_amdgcn_permlane32_swap(a0, b0, false, false); auto r1 = __builtin_amdgcn_permlane32_swap(a1, b1, false, false); \
    u32x4 w = {r0[0], r1[0], r0[1], r1[1]}; OUT = *reinterpret_cast<bf16x8*>(&w); } while (0)
  PK4(p0, 0, pa0); PK4(p0, 8, pa1); PK4(p1, 0, pa2); PK4(p1, 8, pa3);
#undef PK4
}
__device__ __forceinline__ bf16x8 scale_bf16x8(bf16x8 v, float c) {
  u32x4 w = *reinterpret_cast<u32x4*>(&v), o;
#pragma unroll
  for (int i = 0; i < 4; ++i) { const float lo = __uint_as_float(w[i] << 16), hh = __uint_as_float(w[i] & 0xffff0000u); o[i] = cvtpk(lo * c, hh * c); }
  return *reinterpret_cast<bf16x8*>(&o);
}
template <int ND0> __device__ __forceinline__ void qkt(f32x16& p0, f32x16& p1, const char* Ks, const bf16x8* qr, int r32, int hi, int cboff, const f32x16& ci) {
#pragma unroll
  for (int d0 = 0; d0 < ND0; ++d0) { int cb = cboff + (d0 * 16 + hi * 8) * 2;
    bf16x8 b0 = *reinterpret_cast<const bf16x8*>(Ks + KSWZ(r32, cb));
    bf16x8 b1 = *reinterpret_cast<const bf16x8*>(Ks + KSWZ(32 + r32, cb));
    if (d0 == 0) { p0 = __builtin_amdgcn_mfma_f32_32x32x16_bf16(b0, qr[0], ci, 0, 0, 0); p1 = __builtin_amdgcn_mfma_f32_32x32x16_bf16(b1, qr[0], ci, 0, 0, 0); }
    else { p0 = __builtin_amdgcn_mfma_f32_32x32x16_bf16(b0, qr[d0], p0, 0, 0, 0); p1 = __builtin_amdgcn_mfma_f32_32x32x16_bf16(b1, qr[d0], p1, 0, 0, 0); } }
}
template <bool FIRST> __device__ __forceinline__ void partialSM2(f32x16& p0, f32x16& p1, float& m_ref, f32x16& negm, float& alpha) {
  float pmax = max3f(p0[0], p0[1], p1[0]), pmb = max3f(p0[2], p0[3], p1[1]);
  pmax = max3f(pmax, p1[2], p1[3]);
#pragma unroll
  for (int r = 4; r < 16; r += 4) { pmax = max3f(pmax, p0[r], p0[r + 1]); pmb = max3f(pmb, p0[r + 2], p0[r + 3]); pmax = max3f(pmax, p1[r], p1[r + 1]); pmb = max3f(pmb, p1[r + 2], p1[r + 3]); }
  pmax = max3f(pmax, pmb, pmb);
  { auto rr = __builtin_amdgcn_permlane32_swap(__float_as_uint(pmax), __float_as_uint(pmax), false, false);
    pmax = fmaxf(__uint_as_float(rr[0]), __uint_as_float(rr[1])); }
  alpha = 1.f;
  if (FIRST || !__builtin_expect(__all(pmax <= THR), 1)) {
    const float dl = FIRST ? pmax : fmaxf(pmax, 0.f); m_ref += dl; if (!FIRST) alpha = __builtin_amdgcn_exp2f(-dl);
#pragma unroll
    for (int r = 0; r < 16; ++r) { p0[r] -= dl; p1[r] -= dl; negm[r] -= dl; }
  }
#pragma unroll
  for (int r = 0; r < 16; ++r) p0[r] = __builtin_amdgcn_exp2f(p0[r]);
}
__device__ __forceinline__ int v_st(int k, int c) { const int kk = (k & ~0xC) | ((k & 4) << 1) | ((k & 8) >> 1); return ((kk >> 3) * 4 + (c >> 5)) * 512 + ((kk & 7) * 32 + (c & 31)) * 2; }
__device__ __forceinline__ int v_rd_base(int lane) { return ((lane & 3) << 3) | (((lane >> 2) & 3) << 6) | (((lane >> 4) & 1) << 5) | (((lane >> 5) & 1) << 8); }
constexpr int v_rd_off(int d0, int ks, int half) { return d0 * 512 + ks * 4096 + half * 2048; }
template <int OFF> __device__ __forceinline__ s16x4 tr_read(int vb) {
  s16x4 r; asm volatile("ds_read_b64_tr_b16 %0, %1 offset:%2" : "=&v"(r) : "v"(vb), "i"(OFF) : "memory"); return r;
}
#define VRD8(D0, L0, H0, L1, H1, L2, H2, L3, H3) do { L0 = tr_read<v_rd_off(D0, 0, 0)>(vb); H0 = tr_read<v_rd_off(D0, 0, 1)>(vb); L1 = tr_read<v_rd_off(D0, 1, 0)>(vb); H1 = tr_read<v_rd_off(D0, 1, 1)>(vb); \
    L2 = tr_read<v_rd_off(D0, 2, 0)>(vb); H2 = tr_read<v_rd_off(D0, 2, 1)>(vb); L3 = tr_read<v_rd_off(D0, 3, 0)>(vb); H3 = tr_read<v_rd_off(D0, 3, 1)>(vb); } while (0)
#define PK(L, H) (bf16x8){L[0], L[1], L[2], L[3], H[0], H[1], H[2], H[3]}
#define MMA4(OD, L0, H0, L1, H1, L2, H2, L3, H3) do { OD = __builtin_amdgcn_mfma_f32_32x32x16_bf16(pa0, PK(L0, H0), OD, 0, 0, 0); OD = __builtin_amdgcn_mfma_f32_32x32x16_bf16(pa1, PK(L1, H1), OD, 0, 0, 0); \
    OD = __builtin_amdgcn_mfma_f32_32x32x16_bf16(pa2, PK(L2, H2), OD, 0, 0, 0); OD = __builtin_amdgcn_mfma_f32_32x32x16_bf16(pa3, PK(L3, H3), OD, 0, 0, 0); } while (0)
__device__ __forceinline__ void pv_d0(f32x16* o, int vb, bf16x8 pa0, bf16x8 pa1, bf16x8 pa2, bf16x8 pa3) {
  s16x4 a0, a1, a2, a3, a4, a5, a6, a7, b0, b1, b2, b3, b4, b5, b6, b7;
  VRD8(0, a0, a1, a2, a3, a4, a5, a6, a7);
  VRD8(1, b0, b1, b2, b3, b4, b5, b6, b7);
  asm volatile("s_waitcnt lgkmcnt(8)" ::: "memory"); SBAR();
  MMA4(o[0], a0, a1, a2, a3, a4, a5, a6, a7); SBAR();
  VRD8(2, a0, a1, a2, a3, a4, a5, a6, a7);
  asm volatile("s_waitcnt lgkmcnt(8)" ::: "memory"); SBAR();
  MMA4(o[1], b0, b1, b2, b3, b4, b5, b6, b7); SBAR();
  VRD8(3, b0, b1, b2, b3, b4, b5, b6, b7);
  asm volatile("s_waitcnt lgkmcnt(8)" ::: "memory"); SBAR();
  MMA4(o[2], a0, a1, a2, a3, a4, a5, a6, a7); SBAR();
  asm volatile("s_waitcnt lgkmcnt(0)" ::: "memory"); SBAR();
  MMA4(o[3], b0, b1, b2, b3, b4, b5, b6, b7);
}
__device__ __forceinline__ void pv_partial(f32x16* o, int vb, bf16x8 pa0, bf16x8 pa1, bf16x8 pa2, bf16x8 pa3, f32x16& p0, f32x16& p1, float& m_ref, f32x16& negm, float& alpha) {
  s16x4 a0, a1, a2, a3, a4, a5, a6, a7, b0, b1, b2, b3, b4, b5, b6, b7;
  VRD8(0, a0, a1, a2, a3, a4, a5, a6, a7);
  VRD8(1, b0, b1, b2, b3, b4, b5, b6, b7);
  asm volatile("s_waitcnt lgkmcnt(8)" ::: "memory"); SBAR();
  MMA4(o[0], a0, a1, a2, a3, a4, a5, a6, a7);
  float pmax = max3f(p0[0], p0[1], p1[0]), pmb = max3f(p0[2], p0[3], p1[1]);
  pmax = max3f(pmax, p1[2], p1[3]);
#pragma unroll
  for (int r = 4; r < 16; r += 4) { pmax = max3f(pmax, p0[r], p0[r + 1]); pmb = max3f(pmb, p0[r + 2], p0[r + 3]); pmax = max3f(pmax, p1[r], p1[r + 1]); pmb = max3f(pmb, p1[r + 2], p1[r + 3]); }
  pmax = max3f(pmax, pmb, pmb);
  SBAR();
  VRD8(2, a0, a1, a2, a3, a4, a5, a6, a7);
  asm volatile("s_waitcnt lgkmcnt(8)" ::: "memory"); SBAR();
  MMA4(o[1], b0, b1, b2, b3, b4, b5, b6, b7);
  { auto rr = __builtin_amdgcn_permlane32_swap(__float_as_uint(pmax), __float_as_uint(pmax), false, false);
    pmax = fmaxf(__uint_as_float(rr[0]), __uint_as_float(rr[1])); }
  alpha = 1.f;
  if (!__builtin_expect(__all(pmax <= THR), 1)) {
    const float dl = fmaxf(pmax, 0.f); m_ref += dl; alpha = __builtin_amdgcn_exp2f(-dl);
#pragma unroll
    for (int r = 0; r < 16; ++r) { p0[r] -= dl; p1[r] -= dl; negm[r] -= dl; }
  }
  SBAR();
  VRD8(3, b0, b1, b2, b3, b4, b5, b6, b7);
  asm volatile("s_waitcnt lgkmcnt(8)" ::: "memory"); SBAR();
  MMA4(o[2], a0, a1, a2, a3, a4, a5, a6, a7);
#pragma unroll
  for (int r = 0; r < 8; ++r) p0[r] = __builtin_amdgcn_exp2f(p0[r]);
  SBAR();
  asm volatile("s_waitcnt lgkmcnt(0)" ::: "memory"); SBAR();
  MMA4(o[3], b0, b1, b2, b3, b4, b5, b6, b7);
#pragma unroll
  for (int r = 8; r < 16; ++r) p0[r] = __builtin_amdgcn_exp2f(p0[r]);
}
#undef VRD8
#undef PK
#undef MMA4

template <int MODE, int ORD>
__device__ __forceinline__ void attn_unit(const bf16* __restrict__ Qb, const bf16* __restrict__ Kh, const bf16* __restrict__ Vh, bf16* __restrict__ Ob,
                                          int qpos0, int kbeg, int NT, const float* __restrict__ tabsrc, float sinkv, float lam, float oscale,
                                          const float* __restrict__ subg, char* lds) {
  constexpr int ND0 = MODE == 0 ? 4 : 8;
  const float C = (MODE == 0 ? 0.125f : 0.08838834764831845f) * LOG2E;
  int tid_ = threadIdx.x; asm volatile("" : "+v"(tid_));
  const int tid = tid_, wid = __builtin_amdgcn_readfirstlane(tid >> 6), lane = tid & 63; int r32 = lane & 31, hi = lane >> 5;
  const int wq = MODE == 0 ? (wid & 3) : wid, cst = MODE == 0 ? (wid >> 2) : 0;
  char* V_lds = lds + OFF_V; char* K_lds = lds + OFF_K;
  float* wsf = (float*)(lds + OFF_WS) + wid * 64; float* li_l = wsf; float* al_l = wsf + 32;
  float* tab = (float*)(lds + OFF_TAB);
  __syncthreads();
  if (wid >= 4) __builtin_amdgcn_s_setprio(1);
  if (tid < 257) tab[tid] = tabsrc[t5_bucket(tid - 128) * 16] * LOG2E;
  float m_reg = MODE == 0 ? 0.f : sinkv * LOG2E, l_reg = MODE == 0 ? 0.f : 1.f;
  f32x16 o[4] = {}; bf16x8 qr[ND0];
  const bf16* Qw = Qb + (long)(wq * 32 + r32) * LDP + cst * 64 + hi * 8;
#pragma unroll
  for (int d0 = 0; d0 < ND0; ++d0) qr[d0] = scale_bf16x8(ld8(Qw + d0 * 16), C);
  const int qpos = qpos0 + wq * 32 + r32;
  const int qw0 = qpos0 + wq * 32;
  const int cboff = cst * 128;
  int sr = tid >> 4, sc = (tid & 15) * 8, vst0 = v_st(sr, sc), vst1 = v_st(32 + sr, sc);
  int vb0 = (int)(uintptr_t)V_lds + v_rd_base(lane);
  const bf16* Kg = Kh + (long)kbeg * LDP; const bf16* Vg = Vh + (long)kbeg * LDP;
  struct { bf16x8 vs0, vs1, ks0, ks1; } sr_[1];
#define SLOAD(i, k0) do { sr_[i].vs0 = ld8(&Vg[(long)((k0) + sr) * LDP + sc]); sr_[i].vs1 = ld8(&Vg[(long)((k0) + 32 + sr) * LDP + sc]); \
    sr_[i].ks0 = ld8(&Kg[(long)((k0) + sr) * LDP + sc]); sr_[i].ks1 = ld8(&Kg[(long)((k0) + 32 + sr) * LDP + sc]); } while (0)
#define SWRITE(off, i) do { *(bf16x8*)(V_lds + (off) + vst0) = sr_[i].vs0;          \
    *(bf16x8*)(V_lds + (off) + vst1) = sr_[i].vs1; int kc = sc * 2;               \
    *(bf16x8*)(K_lds + (off) + KSWZ(sr, kc)) = sr_[i].ks0;                       \
    *(bf16x8*)(K_lds + (off) + KSWZ(32 + sr, kc)) = sr_[i].ks1; } while (0)
#define SWAIT() asm volatile("s_waitcnt vmcnt(0)" ::: "memory")
#define RESC(a) do { if (__any((a) < 1.f)) { if (hi == 0) al_l[r32] = (a); asm volatile("s_waitcnt lgkmcnt(0)" ::: "memory"); \
    _Pragma("unroll") for (int d = 0; d < 4; ++d) _Pragma("unroll") for (int r = 0; r < 16; ++r) o[d][r] *= al_l[crow(r, hi)]; } } while (0)
  float bL, bR, be_cur = 0.f; f32x16 negm;
#pragma unroll
  for (int r = 0; r < 16; ++r) negm[r] = -m_reg;
#define TCLS(t) const int k0_ = kbeg + (t) * KVBLK; const int rmax_ = k0_ + 63 - qw0, rmin_ = k0_ - qw0 - 31; const bool near_ = (MODE == 1) || (rmax_ > -128 && rmin_ < 128)
#define SETBE(t) do { TCLS(t); const float bt_ = near_ ? 0.f : ((rmax_ <= -128) ? bL : bR); \
    if (bt_ != be_cur) { const float d_ = bt_ - be_cur; _Pragma("unroll") for (int r = 0; r < 16; ++r) negm[r] += d_; be_cur = bt_; } } while (0)
#define BIAS(P0, P1, t) do { TCLS(t); (void)rmin_; (void)rmax_; \
    if (near_) { asm volatile("" ::: "memory");     \
      const int base_ = k0_ - qpos + 128 + 4 * hi; \
      _Pragma("unroll") for (int r = 0; r < 16; ++r) { const int i0 = base_ + (r & 3) + 8 * (r >> 2), i1 = i0 + 32; \
        const int c0 = i0 < 0 ? 0 : (i0 > 256 ? 256 : i0), c1 = i1 < 0 ? 0 : (i1 > 256 ? 256 : i1); \
        const float t0 = P0[r] + tab[c0], t1 = P1[r] + tab[c1]; \
        if (MODE == 1) { P0[r] = (i0 == c0) ? t0 : NEGB; P1[r] = (i1 == c1) ? t1 : NEGB; } else { P0[r] = t0; P1[r] = t1; } } \
      asm volatile("" ::: "memory"); } } while (0)
  f32x16 pA0, pA1, pB0, pB1; float alA, alB; bf16x8 pa0, pa1, pa2, pa3;
  constexpr int SE = 0, SO = 0;
  SLOAD(SE, 0); asm volatile("s_waitcnt vmcnt(0)" ::: "memory"); SWRITE(0, SE); __syncthreads();
  bL = tab[0]; bR = tab[256];
  SETBE(0); qkt<ND0>(pA0, pA1, K_lds, qr, r32, hi, cboff, negm); BIAS(pA0, pA1, 0); partialSM2<MODE == 0>(pA0, pA1, m_reg, negm, alA);
  SLOAD(SO, KVBLK);
  SWAIT(); SWRITE(SLOT, SO); __syncthreads();
  int op = 0, oc = SLOT, on = 2 * SLOT;
#define ROT() do { const int t_ = op; op = oc; oc = on; on = t_; } while (0)
#define TILE_STEP1(PN0, PN1, ALN, PO0, PO1, ALO, TN, LOADS) do { \
      SBAR(); finishSM(PO0, PO1, ALO, l_reg, pa0, pa1, pa2, pa3); SBAR(); LOADS; SETBE(TN); SBAR(); qkt<ND0>(PN0, PN1, K_lds + oc, qr, r32, hi, cboff, negm); SBAR(); \
      BIAS(PN0, PN1, TN); partialSM2<false>(PN0, PN1, m_reg, negm, ALN); SBAR(); pv_d0(o, vb0 + op, pa0, pa1, pa2, pa3); } while (0)
#define MAIN_LOOP(TS) do { \
  for (int j = 1; j + 1 < NT; j += 2) { \
    TS(pB0, pB1, alB, pA0, pA1, alA, j, SLOAD(SO, (j + 1) * KVBLK)); \
    SWAIT(); SWRITE(on, SE); RESC(alB); __syncthreads(); ROT(); \
    TS(pA0, pA1, alA, pB0, pB1, alB, j + 1, SLOAD(SE, (j + 2) * KVBLK)); \
    SWAIT(); SWRITE(on, SO); RESC(alA); __syncthreads(); ROT(); \
  } \
  TS(pB0, pB1, alB, pA0, pA1, alA, NT - 1, (void)0); } while (0)
#define TILE_STEPX(PN0, PN1, ALN, PO0, PO1, ALO, TN, LOADS) do { \
      SBAR(); LOADS; SETBE(TN); SBAR(); qkt<ND0>(PN0, PN1, K_lds + oc, qr, r32, hi, cboff, negm); finishSM(PO0, PO1, ALO, l_reg, pa0, pa1, pa2, pa3); SBAR(); \
      BIAS(PN0, PN1, TN); SBAR(); pv_partial(o, vb0 + op, pa0, pa1, pa2, pa3, PN0, PN1, m_reg, negm, ALN); } while (0)
  MAIN_LOOP(TILE_STEPX);
#undef MAIN_LOOP
#undef TILE_STEPX
#undef TILE_STEP1
#undef SETBE
#undef TCLS
  RESC(alB);
  finishSM(pB0, pB1, alB, l_reg, pa0, pa1, pa2, pa3); SBAR();
  pv_d0(o, vb0 + oc, pa0, pa1, pa2, pa3);
#undef ROT
  if (hi == 0) li_l[r32] = l_reg; asm volatile("s_waitcnt lgkmcnt(0)" ::: "memory");
  float rli[16];
#pragma unroll
  for (int r = 0; r < 16; ++r) rli[r] = __builtin_amdgcn_rcpf(li_l[crow(r, hi)]);
  if (MODE == 1) {
    bf16* Ow = Ob + (long)(wq * 32) * LDO;
#pragma unroll
    for (int r = 0; r < 16; ++r) { const int orow = crow(r, hi);
#pragma unroll
      for (int d0 = 0; d0 < 4; ++d0) { __hip_bfloat16 bv = __float2bfloat16(o[d0][r] * rli[r]); Ow[(long)orow * LDO + d0 * 32 + r32] = *reinterpret_cast<bf16*>(&bv); } }
  } else {
    __syncthreads();
    float* X = (float*)lds + wq * 4096;
    if (cst == 1) {
#pragma unroll
      for (int r = 0; r < 16; ++r) { const int orow = crow(r, hi);
#pragma unroll
        for (int d0 = 0; d0 < 4; ++d0) X[orow * 128 + d0 * 32 + r32] = o[d0][r] * rli[r]; }
    }
    __syncthreads();
    if (cst == 0) {
      float ssq[16];
#pragma unroll
      for (int r = 0; r < 16; ++r) { const int orow = crow(r, hi); float s = 0.f;
#pragma unroll
        for (int d0 = 0; d0 < 4; ++d0) { const float v = o[d0][r] * rli[r] - lam * X[orow * 128 + d0 * 32 + r32]; o[d0][r] = v; s = fmaf(v, v, s); }
        ssq[r] = s; }
#pragma unroll
      for (int r = 0; r < 16; ++r) {
#pragma unroll
        for (int off = 1; off < 32; off <<= 1) ssq[r] += __shfl_xor(ssq[r], off);
      }
      float gg[4];
#pragma unroll
      for (int d0 = 0; d0 < 4; ++d0) gg[d0] = subg[d0 * 32 + r32] * oscale;
      bf16* Ow = Ob + (long)(wq * 32) * LDO;
#pragma unroll
      for (int r = 0; r < 16; ++r) { const int orow = crow(r, hi); const float rs = __builtin_amdgcn_rsqf(ssq[r] * (1.f / 128.f) + 1e-6f);
#pragma unroll
        for (int d0 = 0; d0 < 4; ++d0) { __hip_bfloat16 bv = __float2bfloat16(o[d0][r] * rs * gg[d0]); Ow[(long)orow * LDO + d0 * 32 + r32] = *reinterpret_cast<bf16*>(&bv); } }
    }
  }
  __builtin_amdgcn_s_setprio(0);
#undef SLOAD
#undef SWRITE
#undef SWAIT
#undef RESC
#undef BIAS
}
#undef SBAR
}

#define LAS __attribute__((address_space(3)))
typedef unsigned short bf16;
typedef unsigned v4u __attribute__((ext_vector_type(4)));
typedef float f32x4 __attribute__((ext_vector_type(4)));
constexpr int NWAVES = 8;
constexpr int DM = 2048, SEQ_P = 8192, NB_P = 4, SEQ_S = 4096, NB_S = 2, DEPTH = 2, DFF = 8192, INW = 4608;
constexpr int M_P = NB_P * SEQ_P, M_S = NB_S * SEQ_S, M = M_P + M_S;
constexpr size_t MiB = 1u << 20;
constexpr size_t WS_WIN = 1 * MiB;
constexpr size_t WS_WOUT = WS_WIN + (size_t)DEPTH * INW * DM * 2;
constexpr size_t WS_WF1 = WS_WOUT + (size_t)DEPTH * DM * DM * 2;
constexpr size_t WS_WF2 = WS_WF1 + (size_t)DEPTH * DFF * DM * 2;
constexpr size_t WS_XN = WS_WF2 + (size_t)DEPTH * DM * DFF * 2;
constexpr size_t WS_H = WS_XN + (size_t)M * DM * 2;
constexpr size_t WS_PROJ = WS_H;
constexpr size_t WS_ATT = WS_PROJ + (size_t)M * INW * 2;
constexpr size_t WS_END = WS_H + (size_t)M * DFF * 2;
static_assert(WS_ATT + (size_t)M * DM * 2 <= WS_END, "overlay");
constexpr int LDS_BYTES = 147456;
static_assert(att::ATT_LDS <= 131072, "attention LDS");

__device__ __forceinline__ unsigned f2bf(float f) { unsigned u = __builtin_bit_cast(unsigned, f); return (u + 0x7fffu + ((u >> 16) & 1u)) >> 16; }
__device__ __forceinline__ unsigned pk2(float lo, float hi) { return f2bf(lo) | (f2bf(hi) << 16); }
__device__ __forceinline__ float wave_sum(float v) {
#pragma unroll
    for (int o = 1; o < 64; o <<= 1) v += __shfl_xor(v, o);
    return v;
}
__device__ __forceinline__ void transpose_item(const float* W, int K, int N, bf16* WT, LAS float* scr, int item, int lane) {
    const int nblk = N / 32, kb = item / nblk, nb = item % nblk, k0 = 64 * kb, n0 = 32 * nb;
#pragma unroll 16
    for (int i = 0; i < 32; ++i) { const int kk = 2 * i + (lane >> 5); scr[kk * 33 + (lane & 31)] = W[(size_t)(k0 + kk) * N + n0 + (lane & 31)]; }
    asm volatile("s_waitcnt lgkmcnt(0)" ::: "memory");
    const int c = lane & 7;
#pragma unroll
    for (int j = 0; j < 4; ++j) { const int n = (lane >> 3) + 8 * j; const LAS float* s = scr + (8 * c) * 33 + n;
        v4u o; o.x = pk2(s[0 * 33], s[1 * 33]); o.y = pk2(s[2 * 33], s[3 * 33]); o.z = pk2(s[4 * 33], s[5 * 33]); o.w = pk2(s[6 * 33], s[7 * 33]);
        *(v4u*)(WT + (size_t)(n0 + n) * K + k0 + 8 * c) = o; }
    asm volatile("s_waitcnt lgkmcnt(0)" ::: "memory");
}
__device__ __forceinline__ float xg_row_bf16(const float* xrow, const float* g, bf16* orow, int lane) {
    const f32x4* xr = (const f32x4*)xrow + lane; const f32x4* gr = (const f32x4*)g + lane;
    f32x4 v[8]; float s = 0.f;
#pragma unroll
    for (int j = 0; j < 8; ++j) { v[j] = xr[64 * j]; s += (v[j].x * v[j].x + v[j].y * v[j].y) + (v[j].z * v[j].z + v[j].w * v[j].w); }
    unsigned long long* o8 = (unsigned long long*)orow + lane;
#pragma unroll
    for (int j = 0; j < 8; ++j) { const f32x4 gg = gr[64 * j]; o8[64 * j] = (unsigned long long)pk2(v[j].x * gg.x, v[j].y * gg.y) | ((unsigned long long)pk2(v[j].z * gg.z, v[j].w * gg.w) << 32); }
    return wave_sum(s);
}
#define XB_TMO      128
#define XB_XCNT(j)  (256  + 64 * (j))
#define XB_XSUB(j)  (1280 + 64 * (j))
#define XB_XGEN(j)  (2304 + 64 * (j))
#define XB_TOP      3328
#define XB_TOPGEN   3392
#define XCD_BAR_WORDS 3456
#define XB_SPIN_CAP (1u << 18)

__device__ __forceinline__ unsigned xb_ld(unsigned* p)              { return __hip_atomic_load(p, __ATOMIC_RELAXED, __HIP_MEMORY_SCOPE_AGENT); }
__device__ __forceinline__ unsigned xb_add(unsigned* p, unsigned v) { return __hip_atomic_fetch_add(p, v, __ATOMIC_RELAXED, __HIP_MEMORY_SCOPE_AGENT); }
__device__ __forceinline__ unsigned xb_xcc_id() { return (unsigned)__builtin_amdgcn_s_getreg((3 << 11) | 20) & 0xFu; }
#define XB_SPIN(cond, bar) do { unsigned _sp = 0; while (cond) { __builtin_amdgcn_s_sleep(1); \
    if ((++_sp & 255u) == 0u) { if (xb_ld(&(bar)[XB_TMO])) break; if (_sp > XB_SPIN_CAP) { atomicAdd(&(bar)[XB_TMO], 1u); break; } } } } while (0)

struct XcdBarrier {
    unsigned* bar; unsigned x;
    volatile LAS unsigned* st;
};

__device__ __forceinline__ XcdBarrier xcd_barrier_post(unsigned* bar, volatile LAS unsigned* st) {
    XcdBarrier b; b.bar = bar; b.x = xb_xcc_id(); b.st = st;
    if (threadIdx.x == 0) (void)xb_add(&bar[XB_XCNT(b.x)], 1u);
    return b;
}
__device__ __forceinline__ void xcd_barrier_complete(unsigned* bar, unsigned x, unsigned& nloc, unsigned& nx) {
    const unsigned G = gridDim.x * gridDim.y * gridDim.z;
    unsigned sum, cnt, mine, sp = 0u;
    for (;;) {
        sum = 0u; cnt = 0u; mine = 0u;
#pragma unroll
        for (unsigned j = 0; j < 16; ++j) { const unsigned c = xb_ld(&bar[XB_XCNT(j)]); sum += c; cnt += (c > 0u) ? 1u : 0u; mine = (j == x) ? c : mine; }
        if (sum == G) break;
        __builtin_amdgcn_s_sleep(1);
        if ((++sp & 255u) == 0u) { if (xb_ld(&bar[XB_TMO])) break; if (sp > XB_SPIN_CAP) { atomicAdd(&bar[XB_TMO], 1u); break; } }
    }
    nloc = mine > 0u ? mine : 1u; nx = cnt > 0u ? cnt : 1u;
}

__device__ __forceinline__ void xcd_barrier(const XcdBarrier& b) {
    asm volatile("s_waitcnt vmcnt(0)" ::: "memory");
    __syncthreads();
    if (threadIdx.x == 0) {
        unsigned* bar = b.bar;
        __builtin_amdgcn_s_waitcnt(0);
        unsigned nloc = b.st[0], nx = b.st[1];
        if (nloc == 0u) { xcd_barrier_complete(bar, b.x, nloc, nx); b.st[0] = nloc; b.st[1] = nx; }
        const unsigned old = xb_add(&bar[XB_XSUB(b.x)], 1u);
        const unsigned gen = old / nloc;
        if (old + 1u == (gen + 1u) * nloc) {
            __builtin_amdgcn_fence(__ATOMIC_RELEASE, "agent");
            asm volatile("s_waitcnt vmcnt(0)" ::: "memory");
            const unsigned og = xb_add(&bar[XB_TOP], 1u);
            const unsigned tg = og / nx;
            if (og + 1u == (tg + 1u) * nx) xb_add(&bar[XB_TOPGEN], 1u);
            else XB_SPIN(xb_ld(&bar[XB_TOPGEN]) == tg, bar);
            __builtin_amdgcn_fence(__ATOMIC_ACQUIRE, "agent");
            xb_add(&bar[XB_XGEN(b.x)], 1u);
            asm volatile("s_waitcnt vmcnt(0)" ::: "memory");
        } else {
            XB_SPIN(xb_ld(&bar[XB_XGEN(b.x)]) == gen, bar);
            __builtin_amdgcn_fence(__ATOMIC_ACQUIRE, "agent");
            asm volatile("s_waitcnt vmcnt(0)" ::: "memory");
        }
    }
    __syncthreads();
}
struct Args { const float* in[16]; float* out; unsigned char* ws; int ph_lo, ph_hi; };
constexpr int N_PHASES = 2 + 5 * DEPTH;
constexpr size_t WS_BAR = 900 * 1024;
constexpr size_t WS_SSQ = 0;

__global__ void __launch_bounds__(NWAVES * 64, 2) mega_fwd(Args args) {
    extern __shared__ __attribute__((aligned(16))) unsigned char lds[];
    cg::grid_group grid = cg::this_grid();
    const int tid = threadIdx.x, wave = __builtin_amdgcn_readfirstlane(tid >> 6); int lane = tid & 63;
#define LAUNDER() asm volatile("v_mbcnt_lo_u32_b32 %0, -1, 0\n\tv_mbcnt_hi_u32_b32 %0, -1, %0" : "=v"(lane))
    const int G = gridDim.x, bx = blockIdx.x;
    const int vcu = (G % 8 == 0) ? (bx % 8) * (G / 8) + bx / 8 : bx;
    const int gw = vcu * NWAVES + wave, NGW = G * NWAVES;
    unsigned char* ws = args.ws;
    const float* x_prompt = args.in[0]; const float* x_sample = args.in[1]; const float* rel_bias = args.in[2];
    const float* norm1_g = args.in[3]; const float* w_in = args.in[4];
    const float* lq1 = args.in[5]; const float* lk1 = args.in[6]; const float* lq2 = args.in[7]; const float* lk2 = args.in[8];
    const float* subln_g = args.in[9]; const float* sink = args.in[10]; const float* w_out = args.in[11]; const float* norm2_g = args.in[12];
    const float* w_f1 = args.in[13]; const float* w_f2 = args.in[14]; const float* fin_g = args.in[15];
    float* out = args.out;
    bf16* Win_t = (bf16*)(ws + WS_WIN); bf16* Wout_t = (bf16*)(ws + WS_WOUT); bf16* Wf1_t = (bf16*)(ws + WS_WF1); bf16* Wf2_t = (bf16*)(ws + WS_WF2);
    float* SSQ = (float*)(ws + WS_SSQ);
    bf16* XN = (bf16*)(ws + WS_XN); bf16* HB = (bf16*)(ws + WS_H); bf16* PROJ = (bf16*)(ws + WS_PROJ); bf16* ATT = (bf16*)(ws + WS_ATT);
    const int lo = args.ph_lo, hi = args.ph_hi;
    volatile LAS unsigned* xst = (volatile LAS unsigned*)((LAS unsigned char*)lds + LDS_BYTES - 64);
    if (threadIdx.x < 16) xst[threadIdx.x] = 0u;
    __syncthreads();
    (void)xcd_barrier_post((unsigned*)(ws + WS_BAR), xst);
#define IN(k) (lo <= (k) && (k) < hi)
#define SEAM(k) do { if (IN(k) && IN((k) + 1)) { if ((k) == 0) grid.sync(); else { XcdBarrier xb_; xb_.bar = (unsigned*)(args.ws + WS_BAR); xb_.x = xb_xcc_id(); xb_.st = (volatile LAS unsigned*)((LAS unsigned char*)lds + LDS_BYTES - 64); xcd_barrier(xb_); } } } while (0)

    if (IN(0)) {
        LAUNDER();
        LAS float* scr = (LAS float*)((LAS unsigned char*)lds + wave * 16384);
        constexpr int I_IN = (DM / 64) * (INW / 32), I_OUT = (DM / 64) * (DM / 32), I_F1 = (DM / 64) * (DFF / 32), I_F2 = (DFF / 64) * (DM / 32);
        constexpr int I_L = I_IN + I_OUT + I_F1 + I_F2;
        for (int it = gw; it < DEPTH * I_L; it += NGW) {
            const int l = it / I_L; int r = it % I_L;
            if (r < I_IN) { transpose_item(w_in + (size_t)l * DM * INW, DM, INW, Win_t + (size_t)l * INW * DM, scr, r, lane); continue; } r -= I_IN;
            if (r < I_OUT) { transpose_item(w_out + (size_t)l * DM * DM, DM, DM, Wout_t + (size_t)l * DM * DM, scr, r, lane); continue; } r -= I_OUT;
            if (r < I_F1) { transpose_item(w_f1 + (size_t)l * DM * DFF, DM, DFF, Wf1_t + (size_t)l * DFF * DM, scr, r, lane); continue; } r -= I_F1;
            transpose_item(w_f2 + (size_t)l * DFF * DM, DFF, DM, Wf2_t + (size_t)l * DM * DFF, scr, r, lane);
        }
        for (int i = (vcu * NWAVES * 64 + tid); i < 4 * M; i += G * NWAVES * 64) SSQ[M + i] = 0.f;
        for (int m = gw; m < M; m += NGW) { const float* xr = m < M_P ? x_prompt + (size_t)m * DM : x_sample + (size_t)(m - M_P) * DM; const float sq = xg_row_bf16(xr, norm1_g, XN + (size_t)m * DM, lane); if (lane == 0) SSQ[m] = sq; }
    }
    SEAM(0);
#pragma unroll
    for (int l = 0; l < DEPTH; ++l) {
        const int pb = 1 + 5 * l;
        if (IN(pb)) {
            pg8::Gemm g{XN, Win_t + (size_t)l * INW * DM, M, INW, DM}; pg8::StaticOrder S; S.init(M, INW, G, bx);
            pg8::EpiBf16<0> E{PROJ, INW, SSQ + (size_t)(2 * l) * M};
            pg8::gemm_phase<pg8::EpiBf16<0>, pg8::StaticOrder, true, true>((LAS unsigned char*)lds, g, S, E);
        }
        SEAM(pb);
        if (IN(pb + 1)) {
            LAUNDER();
            const float lambda_init = l == 0 ? 0.2f : (l == 1 ? 0.35550906758f : 0.8f - 0.6f * expf(-0.3f * (float)l));
            float d1 = lq1[l * 64 + lane] * lk1[l * 64 + lane], d2 = lq2[l * 64 + lane] * lk2[l * 64 + lane];
            d1 = wave_sum(d1); d2 = wave_sum(d2);
            const float lam = __uint_as_float(__builtin_amdgcn_readfirstlane(__float_as_uint(expf(d1) - expf(d2) + lambda_init)));
            const float oscl = __uint_as_float(__builtin_amdgcn_readfirstlane(__float_as_uint(1.f - lambda_init)));
#pragma unroll 1
            for (int U = vcu; U < 2560; U += G) {
                int pair, qb, S; size_t row0;
                if (U < 2048) { const int r = U >> 8, v = U & 255, x = v >> 5, cu = v & 31; pair = x * 4 + (r >> 1); qb = (r & 1) * 32 + cu; S = SEQ_P; row0 = (size_t)(pair >> 3) * SEQ_P; }
                else { const int U2 = U - 2048; const int r = U2 >> 8, v = U2 & 255, x = v >> 5, cu = v & 31; pair = x * 2 + r; qb = cu; S = SEQ_S; row0 = (size_t)M_P + (size_t)(pair >> 3) * SEQ_S; }
                const int h = pair & 7;
                if (false) att::attn_unit<0, 0>(PROJ + (row0 + qb * 128) * INW + h * 128, PROJ + row0 * INW + 1024 + h * 128, PROJ + row0 * INW + 2048 + h * 128,
                                  ATT + (row0 + qb * 128) * DM + h * 128, qb * 128, 0, S / 64, rel_bias + h, 0.f, lam, oscl, subln_g + l * 128, (char*)lds);
                else att::attn_unit<0, 1>(PROJ + (row0 + qb * 128) * INW + h * 128, PROJ + row0 * INW + 1024 + h * 128, PROJ + row0 * INW + 2048 + h * 128,
                                  ATT + (row0 + qb * 128) * DM + h * 128, qb * 128, 0, S / 64, rel_bias + h, 0.f, lam, oscl, subln_g + l * 128, (char*)lds);
            }
#pragma unroll 1
            for (int U3 = vcu; U3 < 1280; U3 += G) {
                const int r = U3 >> 8, v = U3 & 255; const int w = v * 5 + r; const int rbk = w >> 3, hq = w & 7, kvh = hq >> 2;
                const size_t grow = (size_t)rbk * 256;
                const bool isP = grow < (size_t)M_P; const int S = isP ? SEQ_P : SEQ_S;
                const size_t row0 = isP ? (grow / SEQ_P) * SEQ_P : (size_t)M_P + ((grow - M_P) / SEQ_S) * SEQ_S;
                const int q0 = (int)(grow - row0);
                const int kb = q0 - 128 < 0 ? 0 : q0 - 128, ke = q0 + 384 > S ? S : q0 + 384;
                if (false) att::attn_unit<1, 0>(PROJ + grow * INW + 3072 + hq * 128, PROJ + row0 * INW + 4096 + kvh * 128, PROJ + row0 * INW + 4352 + kvh * 128,
                                  ATT + grow * DM + 1024 + hq * 128, q0, kb, (ke - kb) / 64, rel_bias + 8 + hq, sink[l * 8 + hq], 0.f, 1.f, nullptr, (char*)lds);
                else att::attn_unit<1, 1>(PROJ + grow * INW + 3072 + hq * 128, PROJ + row0 * INW + 4096 + kvh * 128, PROJ + row0 * INW + 4352 + kvh * 128,
                                  ATT + grow * DM + 1024 + hq * 128, q0, kb, (ke - kb) / 64, rel_bias + 8 + hq, sink[l * 8 + hq], 0.f, 1.f, nullptr, (char*)lds);
            }
            __syncthreads();
        }
        SEAM(pb + 1);
        if (IN(pb + 2)) {
            pg8::Gemm g{ATT, Wout_t + (size_t)l * DM * DM, M, DM, DM}; pg8::StaticOrder S; S.init(M, DM, G, bx);
            pg8::EpiResF32 E{l == 0 ? x_prompt : out, l == 0 ? x_sample : out + (size_t)M_P * DM, M_P, out, XN, norm2_g + l * DM, SSQ + (size_t)(2 * l + 1) * M, nullptr};
            pg8::gemm_phase<pg8::EpiResF32, pg8::StaticOrder, true, true>((LAS unsigned char*)lds, g, S, E);
        }
        SEAM(pb + 2);
        if (IN(pb + 3)) {
            pg8::Gemm g{XN, Wf1_t + (size_t)l * DFF * DM, M, DFF, DM}; pg8::StaticOrder S; S.init(M, DFF, G, bx);
            pg8::EpiBf16<1> E{HB, DFF, nullptr};
            pg8::gemm_phase<pg8::EpiBf16<1>, pg8::StaticOrder, true, true>((LAS unsigned char*)lds, g, S, E);
        }
        SEAM(pb + 3);
        if (IN(pb + 4)) {
            pg8::Gemm g{HB, Wf2_t + (size_t)l * DM * DFF, M, DM, DFF}; pg8::StaticOrder S; S.init(M, DM, G, bx);
            pg8::EpiResF32 E{out, out + (size_t)M_P * DM, M_P, out, l + 1 < DEPTH ? XN : nullptr, l + 1 < DEPTH ? norm1_g + (l + 1) * DM : fin_g, SSQ + (size_t)(2 * l + 2) * M, SSQ + (size_t)(2 * l + 1) * M};
            pg8::gemm_phase<pg8::EpiResF32, pg8::StaticOrder, true, true>((LAS unsigned char*)lds, g, S, E);
        }
        SEAM(pb + 4);
    }
    if (IN(1 + 5 * DEPTH)) {
        LAUNDER();
        const float* sq = SSQ + (size_t)(2 * DEPTH) * M;
        for (int m = gw; m < M; m += NGW) { f32x4* xr = (f32x4*)(out + (size_t)m * DM) + lane; const f32x4* gr = (const f32x4*)fin_g + lane; const float rs = 1.f / sqrtf(sq[m] * (1.f / DM) + 1e-6f);
#pragma unroll
            for (int j = 0; j < 8; ++j) xr[64 * j] = xr[64 * j] * rs * gr[64 * j]; }
    }
#undef IN
#undef SEAM
}

extern "C" void kernel_launch(void* const* d_in, const int* in_sizes, int n_in, void* d_out, int out_size, void* d_ws, size_t ws_size, hipStream_t stream) {
    static int grid = 0;
    if (grid == 0) {
        if (n_in != 16 || in_sizes[0] != M_P * DM || in_sizes[1] != M_S * DM || out_size != M * DM || ws_size < WS_END) {
            fprintf(stderr, "kernel_launch: shape/workspace mismatch: n_in %d in0 %d in1 %d out %d ws %zu (need %zu)\n", n_in, n_in > 0 ? in_sizes[0] : -1, n_in > 1 ? in_sizes[1] : -1, out_size, ws_size, (size_t)WS_END);
            grid = -1; return; }
        int dev = 0, cus = 0, per_cu = 0;
        hipGetDevice(&dev); hipDeviceGetAttribute(&cus, hipDeviceAttributeMultiprocessorCount, dev);
        if (hipFuncSetAttribute((const void*)mega_fwd, hipFuncAttributeMaxDynamicSharedMemorySize, LDS_BYTES) != hipSuccess) { fprintf(stderr, "kernel_launch: hipFuncSetAttribute failed\n"); grid = -1; return; }
        if (hipOccupancyMaxActiveBlocksPerMultiprocessor(&per_cu, (const void*)mega_fwd, NWAVES * 64, LDS_BYTES) != hipSuccess || per_cu < 1) { fprintf(stderr, "kernel_launch: occupancy query gave %d\n", per_cu); per_cu = 1; }
        (void)hipGetLastError();
        grid = cus * per_cu;
    }
    if (grid < 0) return;
    if (hipMemsetAsync((char*)d_ws + WS_BAR, 0, XCD_BAR_WORDS * 4, stream) != hipSuccess) { fprintf(stderr, "kernel_launch: hipMemsetAsync failed\n"); return; }
    Args a{};
    for (int i = 0; i < 16; ++i) a.in[i] = (const float*)d_in[i];
    a.out = (float*)d_out; a.ws = (unsigned char*)d_ws;
#if MK_MULTI
    for (int p = 0; p < N_PHASES; ++p) { a.ph_lo = p; a.ph_hi = p + 1; void* kargs[] = {&a};
        hipError_t e = hipLaunchCooperativeKernel((const void*)mega_fwd, dim3(grid), dim3(NWAVES * 64), kargs, LDS_BYTES, stream);
        if (e != hipSuccess) { fprintf(stderr, "kernel_launch: launch %d failed: %s (grid %d)\n", p, hipGetErrorString(e), grid); break; } }
#else
    a.ph_lo = 0; a.ph_hi = N_PHASES; void* kargs[] = {&a};
    hipError_t e = hipLaunchCooperativeKernel((const void*)mega_fwd, dim3(grid), dim3(NWAVES * 64), kargs, LDS_BYTES, stream);
    if (e != hipSuccess) fprintf(stderr, "kernel_launch: cooperative launch failed: %s (grid %d)\n", hipGetErrorString(e), grid);
#endif
}
```
